# Optimizing an MI355X kernel written in HIP

```python
import math
import jax
import jax.numpy as jnp
from jax import lax
import numpy as np

D_MODEL = 2048
BATCH = 2
SEQ = 4096
DEPTH = 2

GRID_W = 64
CTX_LEN = 256

MLA_HEADS = 8
MLA_Q_RANK = 512
MLA_KV_RANK = 256
MLA_NOPE = 128
MLA_ROPE = 64
MLA_V = 128
MLA_SCALE = 1.0 / math.sqrt(MLA_NOPE + MLA_ROPE)
MLA_Q_BLOCK = 128
ROPE_BASE = 10000.0

RG_WIDTH = 1024
RG_BLOCKS = 8
RG_BS = RG_WIDTH // RG_BLOCKS
RG_CONV = 4
RG_C = 8.0

NA_HEADS = 8
NA_HEAD_DIM = 128
NA_WIDTH = NA_HEADS * NA_HEAD_DIM
NA_WIN_ROWS = 8
NA_WIN_COLS = 16
NA_SCALE = 1.0 / math.sqrt(NA_HEAD_DIM)

FFN_HIDDEN = -(-8 * D_MODEL // (3 * 256)) * 256

NORM_EPS = 1e-6
NEG_INF = -1e30

IN_SECTIONS = (MLA_Q_RANK, MLA_KV_RANK, MLA_ROPE, RG_WIDTH, RG_WIDTH, NA_WIDTH, NA_WIDTH, NA_WIDTH, D_MODEL, D_MODEL, D_MODEL)
IN_WIDTH = MLA_Q_RANK + MLA_KV_RANK + MLA_ROPE + 2 * RG_WIDTH + 3 * NA_WIDTH + 3 * D_MODEL

kernel_name = "hybrid_mla_rglru_natten_prefix_dit_block"


def rms_norm(x, g):
    xf = x.astype(jnp.float32)
    y = xf * lax.rsqrt(jnp.mean(xf * xf, axis=-1, keepdims=True) + NORM_EPS)
    return (y * g.astype(jnp.float32)).astype(x.dtype)


def modulate(x, g, shift, scale):
    return rms_norm(x, g) * (1 + scale) + shift


def ada_params(cond, w_ada, b_ada):
    m = jax.nn.silu(cond) @ w_ada + b_ada
    return [t[:, None, :] for t in jnp.split(m, 6, axis=-1)]


def split_in(p):
    offs = np.cumsum(IN_SECTIONS)[:-1].tolist()
    return jnp.split(p, offs, axis=-1)


def axial_rope_tables(n_tok):
    t = jnp.arange(n_tok, dtype=jnp.int32)
    row = (t // GRID_W).astype(jnp.float32)
    col = (t % GRID_W).astype(jnp.float32)
    n_freq = MLA_ROPE // 4
    inv = ROPE_BASE ** (-jnp.arange(n_freq, dtype=jnp.float32) / n_freq)
    ang = jnp.concatenate([row[:, None] * inv, col[:, None] * inv], axis=-1)
    return jnp.cos(ang), jnp.sin(ang)


def apply_axial_rope(x, cos, sin):
    n_freq = MLA_ROPE // 4
    bshape = (1, cos.shape[0]) + (1,) * (x.ndim - 3) + (2, n_freq)
    cs, sn = cos.reshape(bshape), sin.reshape(bshape)
    xf = x.astype(jnp.float32).reshape(x.shape[:-1] + (2, 2, n_freq))
    x1, x2 = xf[..., 0, :], xf[..., 1, :]
    out = jnp.stack([x1 * cs - x2 * sn, x2 * cs + x1 * sn], axis=-2)
    return out.reshape(x.shape).astype(x.dtype)


def mla_qkv(q_a, kv_a, k_rope, g_q_a, w_q_b, g_kv_a, w_kv_b):
    b, n, _ = q_a.shape
    q = (rms_norm(q_a, g_q_a) @ w_q_b).reshape(b, n, MLA_HEADS, MLA_NOPE + MLA_ROPE)
    kv = (rms_norm(kv_a, g_kv_a) @ w_kv_b).reshape(b, n, MLA_HEADS, MLA_NOPE + MLA_V)
    return q[..., :MLA_NOPE], q[..., MLA_NOPE:], kv[..., :MLA_NOPE], k_rope, kv[..., MLA_NOPE:]


def mla_attend(qn, qr, kn, kr, v):
    s = (jnp.einsum('bqhd,bkhd->bhqk', qn, kn, preferred_element_type=jnp.float32)
         + jnp.einsum('bqhr,bkr->bhqk', qr, kr, preferred_element_type=jnp.float32)) * MLA_SCALE
    p = jax.nn.softmax(s, axis=-1).astype(v.dtype)
    return jnp.einsum('bhqk,bkhd->bqhd', p, v)


def mla_latent(qn, qr, kn, kr, v):
    b, s, h, _ = qn.shape
    nblk = s // MLA_Q_BLOCK
    qn_b = qn.reshape(b, nblk, MLA_Q_BLOCK, h, MLA_NOPE).transpose(1, 0, 2, 3, 4)
    qr_b = qr.reshape(b, nblk, MLA_Q_BLOCK, h, MLA_ROPE).transpose(1, 0, 2, 3, 4)
    out = lax.map(lambda a: mla_attend(a[0], a[1], kn, kr, v), (qn_b, qr_b))
    return out.transpose(1, 0, 2, 3, 4).reshape(b, s, h * MLA_V)


def dense_attend(q, k, v, scale):
    s = jnp.einsum('bqhd,bkhd->bhqk', q, k, preferred_element_type=jnp.float32) * scale
    p = jax.nn.softmax(s, axis=-1).astype(v.dtype)
    return jnp.einsum('bhqk,bkhd->bqhd', p, v)


def short_conv(u, w, b):
    pad_l = RG_CONV // 2
    y = lax.conv_general_dilated(u, w[:, None, :].astype(u.dtype), window_strides=(1,),
                                 padding=[(pad_l, RG_CONV - 1 - pad_l)],
                                 dimension_numbers=('NWC', 'WIO', 'NWC'),
                                 feature_group_count=u.shape[-1])
    return y + b


def rglru_coeffs(u, w_a, b_a, w_x, b_x, lam):
    ub = u.reshape(u.shape[:-1] + (RG_BLOCKS, RG_BS))
    r = jax.nn.sigmoid(jnp.einsum('bnhi,hij->bnhj', ub, w_a.astype(jnp.float32)).reshape(u.shape) + b_a.astype(jnp.float32))
    i = jax.nn.sigmoid(jnp.einsum('bnhi,hij->bnhj', ub, w_x.astype(jnp.float32)).reshape(u.shape) + b_x.astype(jnp.float32))
    log_a = -RG_C * r * jax.nn.softplus(-lam.astype(jnp.float32))
    return jnp.exp(log_a), jnp.sqrt(-jnp.expm1(2.0 * log_a)) * (i * u)


def linear_scan(a, b, h0, reverse):
    def combine(left, right):
        return left[0] * right[0], right[0] * left[1] + right[1]
    a_cum, b_cum = lax.associative_scan(combine, (a, b), reverse=reverse, axis=1)
    return a_cum * h0[:, None, :] + b_cum


def bidir_rglru(u_ctx, u_lat, conv_w, conv_b, rg_wa, rg_ba, rg_wx, rg_bx, rg_lambda):
    uc = short_conv(u_ctx, conv_w, conv_b).astype(jnp.float32)
    ul = short_conv(u_lat, conv_w, conv_b).astype(jnp.float32)
    outs_c, outs_l = [], []
    for d, rev in ((0, False), (1, True)):
        a_c, b_c = rglru_coeffs(uc, rg_wa[d], rg_ba[d], rg_wx[d], rg_bx[d], rg_lambda[d])
        h_c = linear_scan(a_c, b_c, jnp.zeros_like(uc[:, 0]), rev)
        h_end = h_c[:, 0] if rev else h_c[:, -1]
        a_l, b_l = rglru_coeffs(ul, rg_wa[d], rg_ba[d], rg_wx[d], rg_bx[d], rg_lambda[d])
        outs_c.append(h_c)
        outs_l.append(linear_scan(a_l, b_l, h_end, rev))
    return (outs_c[0] + outs_c[1]).astype(u_ctx.dtype), (outs_l[0] + outs_l[1]).astype(u_lat.dtype)


def natten_latent(q, k, v, k_ctx, v_ctx, rpb):
    b, n, h, d = q.shape
    rows = n // GRID_W
    win_r = min(NA_WIN_ROWS, rows)
    r = jnp.arange(rows)
    r_idx = jnp.clip(r - win_r // 2, 0, rows - win_r)[:, None] + jnp.arange(win_r)[None, :]
    col = jnp.arange(GRID_W)
    c_start = jnp.clip(col - NA_WIN_COLS // 2, 0, GRID_W - NA_WIN_COLS)
    col_in = (col[None, :] >= c_start[:, None]) & (col[None, :] < c_start[:, None] + NA_WIN_COLS)
    qg = q.reshape(b, rows, GRID_W, h, d)
    kg = k.reshape(b, rows, GRID_W, h, d)[:, r_idx]
    vg = v.reshape(b, rows, GRID_W, h, d)[:, r_idx]
    s_lat = jnp.einsum('brqhd,brkwhd->brhqkw', qg, kg, preferred_element_type=jnp.float32) * NA_SCALE
    dr = r_idx - r[:, None] + (NA_WIN_ROWS - 1)
    dc = jnp.clip(col[None, :] - col[:, None] + (NA_WIN_COLS - 1), 0, 2 * NA_WIN_COLS - 2)
    bias = rpb[:, dr[:, None, :, None], dc[None, :, None, :]].astype(jnp.float32)
    s_lat = jnp.where(col_in[:, None, :], s_lat + bias.transpose(1, 0, 2, 3, 4), NEG_INF)
    s_ctx = jnp.einsum('brqhd,bjhd->brhqj', qg, k_ctx, preferred_element_type=jnp.float32) * NA_SCALE
    n_win = win_r * GRID_W
    s = jnp.concatenate([s_lat.reshape(b, rows, h, GRID_W, n_win), s_ctx], axis=-1)
    p = jax.nn.softmax(s, axis=-1).astype(v.dtype)
    p_lat = p[..., :n_win].reshape(b, rows, h, GRID_W, win_r, GRID_W)
    out = (jnp.einsum('brhqkw,brkwhd->brqhd', p_lat, vg)
           + jnp.einsum('brhqj,bjhd->brqhd', p[..., n_win:], v_ctx))
    return out.reshape(b, n, h * d)


def merge_branches(g_mla, g_rg, g_na, mla_o, rg_o, na_o, w_mla_o, w_rg_o, w_na_o, w_out):
    y = (jax.nn.sigmoid(g_mla) * (mla_o @ w_mla_o)
         + jax.nn.sigmoid(g_rg) * (rg_o @ w_rg_o)
         + jax.nn.sigmoid(g_na) * (na_o @ w_na_o))
    return y @ w_out


def ffn_sublayer(x, shift, scale, gate, g_pre, g_post, w_gate, w_up, w_down):
    h = modulate(x, g_pre, shift, scale)
    y = (jax.nn.silu(h @ w_gate) * (h @ w_up)) @ w_down
    return x + gate * rms_norm(y, g_post)


def trunk_layer(xc, xl, mods_c, mods_l, cos, sin, with_ctx_out,
                g_mix_pre, g_mix_post, g_ffn_pre, g_ffn_post, w_in, g_q_a, w_q_b, g_kv_a, w_kv_b,
                w_mla_o, conv_w, conv_b, rg_wa, rg_ba, rg_wx, rg_bx, rg_lambda, w_rg_o,
                na_rpb, w_na_o, w_out, w_ffn_gate, w_ffn_up, w_ffn_down):
    sh1c, sc1c, gt1c, sh2c, sc2c, gt2c = mods_c
    sh1l, sc1l, gt1l, sh2l, sc2l, gt2l = mods_l
    b, n_ctx, _ = xc.shape
    n_lat = xl.shape[1]
    pc = split_in(modulate(xc, g_mix_pre, sh1c, sc1c) @ w_in)
    pl = split_in(modulate(xl, g_mix_pre, sh1l, sc1l) @ w_in)
    qn_c, qr_c, kn_c, kr_c, v_c = mla_qkv(pc[0], pc[1], pc[2], g_q_a, w_q_b, g_kv_a, w_kv_b)
    qn_l, qr_l, kn_l, kr_l, v_l = mla_qkv(pl[0], pl[1], pl[2], g_q_a, w_q_b, g_kv_a, w_kv_b)
    qr_l = apply_axial_rope(qr_l, cos, sin)
    kr_l = apply_axial_rope(kr_l, cos, sin)
    mla_l = mla_latent(qn_l, qr_l, jnp.concatenate([kn_c, kn_l], axis=1),
                       jnp.concatenate([kr_c, kr_l], axis=1), jnp.concatenate([v_c, v_l], axis=1))
    rec_c, rec_l = bidir_rglru(pc[3], pl[3], conv_w, conv_b, rg_wa, rg_ba, rg_wx, rg_bx, rg_lambda)
    rg_l = jax.nn.gelu(pl[4]) * rec_l
    na_shape_c = (b, n_ctx, NA_HEADS, NA_HEAD_DIM)
    na_shape_l = (b, n_lat, NA_HEADS, NA_HEAD_DIM)
    nk_c, nv_c = pc[6].reshape(na_shape_c), pc[7].reshape(na_shape_c)
    na_l = natten_latent(pl[5].reshape(na_shape_l), pl[6].reshape(na_shape_l), pl[7].reshape(na_shape_l),
                         nk_c, nv_c, na_rpb)
    yl = merge_branches(pl[8], pl[9], pl[10], mla_l, rg_l, na_l, w_mla_o, w_rg_o, w_na_o, w_out)
    xl = xl + gt1l * rms_norm(yl, g_mix_post)
    xl = ffn_sublayer(xl, sh2l, sc2l, gt2l, g_ffn_pre, g_ffn_post, w_ffn_gate, w_ffn_up, w_ffn_down)
    if with_ctx_out:
        mla_c = mla_attend(qn_c, qr_c, kn_c, kr_c, v_c).reshape(b, n_ctx, MLA_HEADS * MLA_V)
        rg_c = jax.nn.gelu(pc[4]) * rec_c
        na_c = dense_attend(pc[5].reshape(na_shape_c), nk_c, nv_c, NA_SCALE).reshape(b, n_ctx, NA_WIDTH)
        yc = merge_branches(pc[8], pc[9], pc[10], mla_c, rg_c, na_c, w_mla_o, w_rg_o, w_na_o, w_out)
        xc = xc + gt1c * rms_norm(yc, g_mix_post)
        xc = ffn_sublayer(xc, sh2c, sc2c, gt2c, g_ffn_pre, g_ffn_post, w_ffn_gate, w_ffn_up, w_ffn_down)
    return xc, xl


def setup_inputs(seed: int = 0) -> dict:
    key = jax.random.key(seed)
    ks = jax.random.split(key, 40)
    counter = [0]

    def nk():
        k = ks[counter[0]]
        counter[0] += 1
        return k

    def nrm(shape, scale):
        return jax.random.normal(nk(), shape, jnp.float32) * scale

    def gain(shape):
        return 1.0 + nrm(shape, 0.02)

    L, D = DEPTH, D_MODEL
    x = nrm((BATCH, SEQ, D), 1.0)
    c = nrm((BATCH, D), 1.0)
    ctx = nrm((BATCH, CTX_LEN, D), 1.0)
    c_ctx = nrm((D,), 1.0)
    w_ada = nrm((L, D, 6 * D), D ** -0.5)
    b_ada = nrm((L, 6 * D), 0.01)
    g_mix_pre = gain((L, D))
    g_mix_post = gain((L, D))
    g_ffn_pre = gain((L, D))
    g_ffn_post = gain((L, D))
    w_in = nrm((L, D, IN_WIDTH), D ** -0.5)
    g_q_a = gain((L, MLA_Q_RANK))
    w_q_b = nrm((L, MLA_Q_RANK, MLA_HEADS * (MLA_NOPE + MLA_ROPE)), MLA_Q_RANK ** -0.5)
    g_kv_a = gain((L, MLA_KV_RANK))
    w_kv_b = nrm((L, MLA_KV_RANK, MLA_HEADS * (MLA_NOPE + MLA_V)), MLA_KV_RANK ** -0.5)
    w_mla_o = nrm((L, MLA_HEADS * MLA_V, D), (MLA_HEADS * MLA_V) ** -0.5)
    conv_w = nrm((L, RG_CONV, RG_WIDTH), RG_CONV ** -0.5)
    conv_b = nrm((L, RG_WIDTH), 0.01)
    rg_wa = nrm((L, 2, RG_BLOCKS, RG_BS, RG_BS), RG_BS ** -0.5)
    rg_ba = nrm((L, 2, RG_WIDTH), 0.01)
    rg_wx = nrm((L, 2, RG_BLOCKS, RG_BS, RG_BS), RG_BS ** -0.5)
    rg_bx = nrm((L, 2, RG_WIDTH), 0.01)
    u = jax.random.uniform(nk(), (L, 2, RG_WIDTH), jnp.float32, 0.9, 0.999)
    a_base = u ** (1.0 / RG_C)
    rg_lambda = jnp.log(a_base) - jnp.log1p(-a_base)
    w_rg_o = nrm((L, RG_WIDTH, D), RG_WIDTH ** -0.5)
    na_rpb = nrm((L, NA_HEADS, 2 * NA_WIN_ROWS - 1, 2 * NA_WIN_COLS - 1), 0.1)
    w_na_o = nrm((L, NA_WIDTH, D), NA_WIDTH ** -0.5)
    w_out = nrm((L, D, D), D ** -0.5)
    w_ffn_gate = nrm((L, D, FFN_HIDDEN), D ** -0.5)
    w_ffn_up = nrm((L, D, FFN_HIDDEN), D ** -0.5)
    w_ffn_down = nrm((L, FFN_HIDDEN, D), FFN_HIDDEN ** -0.5)
    return {"x": x, "c": c, "ctx": ctx, "c_ctx": c_ctx, "w_ada": w_ada, "b_ada": b_ada,
            "g_mix_pre": g_mix_pre, "g_mix_post": g_mix_post, "g_ffn_pre": g_ffn_pre, "g_ffn_post": g_ffn_post,
            "w_in": w_in, "g_q_a": g_q_a, "w_q_b": w_q_b, "g_kv_a": g_kv_a, "w_kv_b": w_kv_b,
            "w_mla_o": w_mla_o, "conv_w": conv_w, "conv_b": conv_b, "rg_wa": rg_wa, "rg_ba": rg_ba,
            "rg_wx": rg_wx, "rg_bx": rg_bx, "rg_lambda": rg_lambda, "w_rg_o": w_rg_o,
            "na_rpb": na_rpb, "w_na_o": w_na_o, "w_out": w_out,
            "w_ffn_gate": w_ffn_gate, "w_ffn_up": w_ffn_up, "w_ffn_down": w_ffn_down}


def reference(x, c, ctx, c_ctx, w_ada, b_ada, g_mix_pre, g_mix_post, g_ffn_pre, g_ffn_post,
              w_in, g_q_a, w_q_b, g_kv_a, w_kv_b, w_mla_o, conv_w, conv_b, rg_wa, rg_ba,
              rg_wx, rg_bx, rg_lambda, w_rg_o, na_rpb, w_na_o, w_out, w_ffn_gate, w_ffn_up, w_ffn_down):
    cos, sin = axial_rope_tables(x.shape[1])
    xc, xl = ctx, x
    for i in range(DEPTH):
        mods_l = ada_params(c, w_ada[i], b_ada[i])
        mods_c = ada_params(c_ctx[None, :], w_ada[i], b_ada[i])
        xc, xl = trunk_layer(
            xc, xl, mods_c, mods_l, cos, sin, i < DEPTH - 1,
            g_mix_pre=g_mix_pre[i], g_mix_post=g_mix_post[i], g_ffn_pre=g_ffn_pre[i], g_ffn_post=g_ffn_post[i],
            w_in=w_in[i], g_q_a=g_q_a[i], w_q_b=w_q_b[i], g_kv_a=g_kv_a[i], w_kv_b=w_kv_b[i],
            w_mla_o=w_mla_o[i], conv_w=conv_w[i], conv_b=conv_b[i], rg_wa=rg_wa[i], rg_ba=rg_ba[i],
            rg_wx=rg_wx[i], rg_bx=rg_bx[i], rg_lambda=rg_lambda[i], w_rg_o=w_rg_o[i],
            na_rpb=na_rpb[i], w_na_o=w_na_o[i], w_out=w_out[i],
            w_ffn_gate=w_ffn_gate[i], w_ffn_up=w_ffn_up[i], w_ffn_down=w_ffn_down[i])
    return xl
```

```cpp
#define DUPMASK 0x0u
#include <hip/hip_runtime.h>
#include <hip/hip_cooperative_groups.h>
#include <cstdio>
#include <cstdint>
namespace cg = cooperative_groups;

#define LAS __attribute__((address_space(3)))
typedef unsigned short bf16_t;
typedef short bf16x8 __attribute__((ext_vector_type(8)));
typedef short s16x4 __attribute__((ext_vector_type(4)));
typedef float f32x2 __attribute__((ext_vector_type(2)));
typedef float f32x4 __attribute__((ext_vector_type(4)));
typedef float f32x16 __attribute__((ext_vector_type(16)));
typedef unsigned u32x2 __attribute__((ext_vector_type(2)));
typedef unsigned u32x4 __attribute__((ext_vector_type(4)));

constexpr int DM = 2048, SEQ = 4096, CTX = 256, RPB = 4352  , MROWS = 8704, INW = 12096, INP = 12288, FF = 5632;
constexpr int C_KVA = 512, C_KR = 768, C_U = 832, C_RGG = 1856, C_NQ = 2880, C_NK = 3904, C_NV = 4928, C_G0 = 5952;
constexpr float EPS = 1e-6f;
constexpr int NTHR = 512, NWAVES = 8;
constexpr int LDS_BYTES = 147456;

constexpr size_t MiB = (size_t)1 << 20;
constexpr size_t WS_MODS = 0, WS_SPT = 512 * 1024, WS_BAR = 768 * 1024, BAR_BYTES = 16384, WS_ROPE = 1 * MiB, WS_RS = 2 * MiB, WS_AGG = 3 * MiB, WS_XC = 10 * MiB, WS_W = 14 * MiB;
constexpr size_t W_IN = 0, W_Q = 48 * MiB, W_KV = W_Q + 1536 * 1024, W_G = W_KV + 1 * MiB, W_MRG = W_G + 2 * MiB, W_OUT = W_MRG + 12 * MiB, W_GU = W_OUT + 8 * MiB,
                 W_DN = W_GU + 44 * MiB, W_LAYER = W_DN + 22 * MiB;
constexpr size_t WS_R1 = WS_W + 2 * W_LAYER;
constexpr size_t WS_R2 = WS_R1 + 204 * MiB;
constexpr size_t R2_UC = 0, R2_Q = 17 * MiB, R2_KF = R2_Q + 8704 * 1536 * 2, R2_VM = 68 * MiB, R2_H = 0, R2_Y = 34 * MiB;
constexpr size_t WS_R3 = WS_R2 + 85 * MiB;
constexpr size_t WS_MRN = WS_R3 + 136 * MiB;
constexpr size_t WS_ZS = WS_MRN + 51 * MiB;
constexpr size_t WS_END = WS_ZS + 16 * MiB;

struct Params { const float* in[30]; float* out; unsigned char* ws; };

__device__ __forceinline__ unsigned f2bf(float f) { unsigned u = __builtin_bit_cast(unsigned, f); return (u + 0x7fffu + ((u >> 16) & 1u)) >> 16; }
__device__ __forceinline__ unsigned pk2(float lo, float hi) { return f2bf(lo) | (f2bf(hi) << 16); }
__device__ __forceinline__ float bf2f(unsigned b) { return __builtin_bit_cast(float, b << 16); }
__device__ __forceinline__ float bflo(unsigned w) { return __builtin_bit_cast(float, w << 16); }
__device__ __forceinline__ float bfhi(unsigned w) { return __builtin_bit_cast(float, w & 0xffff0000u); }
__device__ __forceinline__ unsigned cvt_pk_bf16(float lo, float hi) { unsigned r; asm volatile("v_cvt_pk_bf16_f32 %0, %1, %2" : "=v"(r) : "v"(lo), "v"(hi)); return r; }
__device__ __forceinline__ float sigmoidf_(float x) { return 1.f / (1.f + __expf(-x)); }
__device__ __forceinline__ int tid_opaque() { int t = threadIdx.x; asm volatile("" : "+v"(t)); return t; }
__device__ __forceinline__ float wave_sum(float v) {
#pragma unroll
    for (int o = 1; o < 64; o <<= 1) v += __shfl_xor(v, o);
    return v;
}
template <int CTRL> __device__ __forceinline__ float dppf(float v) { return __builtin_bit_cast(float, __builtin_amdgcn_update_dpp(0, __builtin_bit_cast(int, v), CTRL, 0xF, 0xF, true)); }
template <int SFT> __device__ __forceinline__ float lane_xor16(float v) {
    if constexpr (SFT == 0) return dppf<0xB1>(v);
    else if constexpr (SFT == 1) return dppf<0x4E>(v);
    else if constexpr (SFT == 2) return dppf<0x1B>(dppf<0x141>(v));
    else return dppf<0x141>(dppf<0x140>(v));
}
#define LDS_WAIT() asm volatile("s_waitcnt lgkmcnt(0)" ::: "memory")

namespace pg8 {
constexpr int BM = 256, BK = 64, HALF = 128, HTB = HALF * BK * 2, NXCD = 8, WGM = 8;
__device__ __forceinline__ int lds_byte(int r, int c) { const int st = (r >> 4) * 2 + (c >> 5), rr = r & 15, cc = c & 31, ob = rr * 64 + cc * 2; return st * 1024 + (ob ^ (((ob >> 9) & 1) << 5)); }
__device__ __forceinline__ void stage_rc(int b, int& R, int& C) { const int st = b / 1024, sb = b % 1024, swz = sb ^ (((sb >> 9) & 1) << 5); R = (st >> 1) * 16 + swz / 64; C = (st & 1) * 32 + (swz % 64) / 2; }
__device__ __forceinline__ int perm32(int rho) { const int n = rho >> 4, i = rho & 15; return 8 * (i >> 2) + 4 * n + (i & 3); }

struct Unit { int pm, pn; };
struct Gemm { const bf16_t* A; const bf16_t* Bt; int lda, ldb, K, amode; };
struct Order {
    int nM, nN, nwg, G, c, mskip, tri;
    __device__ void init(int nM_, int nN_, int G_, int c_, int mskip_, int tri_ = 0) { nM = nM_; nN = nN_; nwg = nM * nN; G = G_; c = c_; mskip = mskip_; tri = tri_; }
    __device__ bool next(int i0, Unit& u) const {
        const int i = tri ? i0 / 3 : i0, ksub = tri ? i0 - 3 * i : 0;
        const long L = (long)i * G + c; if (L >= nwg) return false;
        int wgid = (int)L; { const int q = nwg / NXCD, r = nwg % NXCD, xcd = wgid % NXCD, off = wgid / NXCD; wgid = (xcd < r ? xcd * (q + 1) : r * (q + 1) + (xcd - r) * q) + off; }
        const int nig = WGM * nN, gid = wgid / nig, fm = gid * WGM, gsz = (nM - fm) < WGM ? (nM - fm) : WGM;
        u.pm = fm + ((wgid % nig) % gsz); u.pn = (wgid % nig) / gsz;
        if (mskip == 1) u.pm += 1 + (u.pm >= 16 ? 1 : 0);
        else if (mskip == 2) u.pm *= 17;
        u.pn += 8 * ksub;
        return true;
    }
};

template <class Epi>
__device__ __forceinline__ void gemm_phase(LAS unsigned char* lds, const Gemm g, const Order& S, const Epi& E) {
    const int tid = tid_opaque(), wid = __builtin_amdgcn_readfirstlane(tid >> 6), lane = tid & 63, wr = wid >> 2, wc = wid & 3, fr = lane & 15, fq = lane >> 4;
    const int K = g.K, nt = K / BK;
    unsigned voffA[2], voffB[2];
#pragma unroll
    for (int i = 0; i < 2; ++i) { int R, C; stage_rc(tid * 16 + i * 8192, R, C); const int Rb = Epi::PERM ? ((R & ~31) + perm32(R & 31)) : R;
        voffA[i] = (unsigned)(R * g.lda + C) * 2u; voffB[i] = (unsigned)(Rb * g.ldb + C) * 2u; }
    const size_t kstep = (size_t)(BK * 2);
    const size_t hstepA = (size_t)HALF * g.lda * 2, tstepA = 2 * hstepA;
    const size_t hstepB = (size_t)HALF * g.ldb * 2, tstepB = 2 * hstepB;
    const unsigned ldsw = (unsigned)wid * 1024u;
    const int aoff = lds_byte(wr * 64 + fr, fq * 8), boff = lds_byte(wc * 32 + fr, fq * 8);
#define PG8_SA(b, h) (((b) * 2 + (h)) * HTB)
#define PG8_SB(b, h) ((4 + (b) * 2 + (h)) * HTB)
#define PG8_STAGE(bufoff, gbase, voff) do { _Pragma("unroll") for (int _i = 0; _i < 2; ++_i) \
        __builtin_amdgcn_global_load_lds((const unsigned*)((const char*)(gbase) + (voff)[_i]), (LAS unsigned*)(lds + (bufoff) + ldsw + _i * 8192), 16, 0, 0); } while (0)
#define PG8_LDA(dst, b, h) do { _Pragma("unroll") for (int m = 0; m < 4; ++m) _Pragma("unroll") for (int k = 0; k < 2; ++k) dst[m][k] = *(const LAS bf16x8*)(lds + PG8_SA(b, h) + aoff + m * 2048 + k * 1024); } while (0)
#define PG8_LDB(dst, b, h) do { _Pragma("unroll") for (int n = 0; n < 2; ++n) _Pragma("unroll") for (int k = 0; k < 2; ++k) dst[n][k] = *(const LAS bf16x8*)(lds + PG8_SB(b, h) + boff + n * 2048 + k * 1024); } while (0)
#define PG8_MMA(ai, bj, At, Bt) do { __builtin_amdgcn_s_setprio(1); _Pragma("unroll") for (int m = 0; m < 4; ++m) _Pragma("unroll") for (int n = 0; n < 2; ++n) _Pragma("unroll") for (int k = 0; k < 2; ++k) \
        acc[ai][bj][m][n] = __builtin_amdgcn_mfma_f32_16x16x32_bf16(Bt[n][k], At[m][k], acc[ai][bj][m][n], 0, 0, 0); __builtin_amdgcn_s_setprio(0); } while (0)
#define PG8_WAIT_V(n) asm volatile("s_waitcnt vmcnt(" #n ")" ::: "memory")
#define PG8_WAIT_L(n) asm volatile("s_waitcnt lgkmcnt(" #n ")" ::: "memory")
#define PG8_BAR __builtin_amdgcn_s_barrier()
#define PG8_SCHED __builtin_amdgcn_sched_barrier(0)
#define PG8_APTR(u) ((const char*)g.A + (size_t)(u).pm * tstepA + (g.amode == 1 ? (size_t)((((u).pn & 7) >> 1) * 512) : g.amode == 2 ? (size_t)((u).pn >> 3) * (size_t)K * 2 : g.amode == 3 ? (size_t)((u).pn >> 3) * ((size_t)MROWS * 1024 * 2) : (size_t)0))
#define PG8_BPTR(u) ((const char*)g.Bt + (g.amode == 2 ? (size_t)((u).pn & 7) * tstepB + (size_t)((u).pn >> 3) * (size_t)K * 2 : g.amode == 3 ? (size_t)((u).pn & 7) * tstepB + (size_t)((u).pn >> 3) * ((size_t)DM * 1024 * 2) : (size_t)(u).pn * tstepB))
    Unit cur, nxt; int ui = 0;
    if (!S.next(0, cur)) return;
    f32x4 acc[2][2][4][2];
#pragma unroll
    for (int a = 0; a < 2; ++a)
#pragma unroll
        for (int b = 0; b < 2; ++b)
#pragma unroll
            for (int m = 0; m < 4; ++m)
#pragma unroll
                for (int n = 0; n < 2; ++n) acc[a][b][m][n] = (f32x4){0.f, 0.f, 0.f, 0.f};
    bf16x8 At[4][2], B0[2][2], B1[2][2];
    const char* cA = PG8_APTR(cur); const char* cB = PG8_BPTR(cur);
    PG8_STAGE(PG8_SB(0, 0), cB, voffB); PG8_STAGE(PG8_SB(0, 1), cB + hstepB, voffB); PG8_STAGE(PG8_SA(0, 0), cA, voffA); PG8_STAGE(PG8_SA(0, 1), cA + hstepA, voffA);
    if (wr == 1) PG8_BAR;
    PG8_WAIT_V(2); PG8_BAR;
    PG8_STAGE(PG8_SB(1, 0), cB + kstep, voffB); PG8_STAGE(PG8_SA(1, 0), cA + kstep, voffA); PG8_STAGE(PG8_SB(1, 1), cB + hstepB + kstep, voffB);
    PG8_WAIT_V(6); PG8_BAR;
    for (;;) {
        const bool has_next = S.next(ui + 1, nxt);
        const char* nA = has_next ? PG8_APTR(nxt) : cA; const char* nB = has_next ? PG8_BPTR(nxt) : cB;
#pragma unroll 1
        for (int t = 0; t < nt; t += 2) {
            const bool last = (t == nt - 2);
            const char* a1 = cA + (size_t)(t + 1) * kstep;
            const char* a2 = last ? nA : cA + (size_t)(t + 2) * kstep; const char* b2 = last ? nB : cB + (size_t)(t + 2) * kstep;
            const char* a3 = a2 + kstep; const char* b3 = b2 + kstep;
            PG8_LDB(B0, 0, 0); PG8_LDB(B1, 0, 1); PG8_SCHED; PG8_LDA(At, 0, 0); PG8_STAGE(PG8_SA(1, 1), a1 + hstepA, voffA);
            PG8_WAIT_V(8); PG8_WAIT_L(0); PG8_BAR; PG8_MMA(0, 0, At, B0); PG8_MMA(0, 1, At, B1); PG8_BAR; PG8_SCHED;
            PG8_LDA(At, 0, 1); PG8_STAGE(PG8_SB(0, 0), b2, voffB); PG8_STAGE(PG8_SB(0, 1), b2 + hstepB, voffB); PG8_STAGE(PG8_SA(0, 0), a2, voffA);
            PG8_WAIT_V(8); PG8_WAIT_L(0); PG8_BAR; PG8_MMA(1, 0, At, B0); PG8_MMA(1, 1, At, B1); PG8_BAR; PG8_SCHED;
            PG8_LDB(B0, 1, 0); PG8_LDB(B1, 1, 1); PG8_SCHED; PG8_LDA(At, 1, 0); PG8_STAGE(PG8_SA(0, 1), a2 + hstepA, voffA);
            PG8_WAIT_V(8); PG8_WAIT_L(0); PG8_BAR; PG8_MMA(0, 0, At, B0); PG8_MMA(0, 1, At, B1); PG8_BAR; PG8_SCHED;
            PG8_LDA(At, 1, 1); PG8_STAGE(PG8_SB(1, 0), b3, voffB); PG8_STAGE(PG8_SB(1, 1), b3 + hstepB, voffB); PG8_STAGE(PG8_SA(1, 0), a3, voffA);
            PG8_WAIT_V(8); PG8_WAIT_L(0); PG8_BAR; PG8_MMA(1, 0, At, B0); PG8_MMA(1, 1, At, B1); PG8_BAR; PG8_SCHED;
        }
        if (wr == 0) PG8_BAR;
        E(acc, cur, wr, wc, fr, fq);
        if (!has_next) break;
#pragma unroll
        for (int a = 0; a < 2; ++a)
#pragma unroll
            for (int b = 0; b < 2; ++b)
#pragma unroll
                for (int m = 0; m < 4; ++m)
#pragma unroll
                    for (int n = 0; n < 2; ++n) acc[a][b][m][n] = (f32x4){0.f, 0.f, 0.f, 0.f};
        cur = nxt; cA = nA; cB = nB; ++ui;
        if (wr == 1) PG8_BAR;
    }
    PG8_WAIT_V(0);
    PG8_BAR;
#undef PG8_SA
#undef PG8_SB
#undef PG8_STAGE
#undef PG8_LDA
#undef PG8_LDB
#undef PG8_MMA
#undef PG8_WAIT_V
#undef PG8_WAIT_L
#undef PG8_BAR
#undef PG8_SCHED
#undef PG8_APTR
#undef PG8_BPTR
}

typedef const f32x4 (&AccRef)[2][2][4][2];

struct EpiP {
    static constexpr bool PERM = true;
    bf16_t* O; int ldc;
    __device__ __forceinline__ void operator()(AccRef acc, const Unit& u, int wr, int wc, int fr, int fq) const {
        const int row0 = u.pm * BM + wr * 64 + fr, col0 = u.pn * BM + wc * 32 + 8 * fq;
#pragma unroll
        for (int ai = 0; ai < 2; ++ai)
#pragma unroll
            for (int m = 0; m < 4; ++m) { bf16_t* rowp = O + (size_t)(row0 + ai * HALF + m * 16) * ldc + col0;
#pragma unroll
                for (int bj = 0; bj < 2; ++bj) { const f32x4 v0 = acc[ai][bj][m][0], v1 = acc[ai][bj][m][1];
                    u32x4 w; w.x = cvt_pk_bf16(v0[0], v0[1]); w.y = cvt_pk_bf16(v0[2], v0[3]); w.z = cvt_pk_bf16(v1[0], v1[1]); w.w = cvt_pk_bf16(v1[2], v1[3]);
                    *(u32x4*)(rowp + bj * HALF) = w; } }
    }
};
struct EpiQ {
    static constexpr bool PERM = true;
    bf16_t* Q; const float* rs; const float* cosT; const float* sinT;
    __device__ __forceinline__ void operator()(AccRef acc, const Unit& u, int wr, int wc, int fr, int fq) const {
        const int row0 = u.pm * BM + wr * 64 + fr;
#pragma unroll
        for (int ai = 0; ai < 2; ++ai)
#pragma unroll
            for (int m = 0; m < 4; ++m) { const int row = row0 + ai * HALF + m * 16; const int rr = row % RPB; const bool lat = rr >= CTX; const int t = rr - CTX; const float s = rs[row];
#pragma unroll
                for (int bj = 0; bj < 2; ++bj) { const int c = u.pn * BM + bj * HALF + wc * 32 + 8 * fq; const int d = c % 192;
                    f32x4 v0 = acc[ai][bj][m][0] * s, v1 = acc[ai][bj][m][1] * s;
                    if (d >= 128 && lat) { const int p = d - 128, axis = p >> 5, f0 = (p & 31) >> 1; const size_t ti = (size_t)t * 32 + axis * 16 + f0;
                        const f32x4 cs = *(const f32x4*)(cosT + ti), sn = *(const f32x4*)(sinT + ti);
                        f32x4 r0, r1;
                        r0[0] = v0[0] * cs[0] - v0[1] * sn[0]; r0[1] = v0[1] * cs[0] + v0[0] * sn[0];
                        r0[2] = v0[2] * cs[1] - v0[3] * sn[1]; r0[3] = v0[3] * cs[1] + v0[2] * sn[1];
                        r1[0] = v1[0] * cs[2] - v1[1] * sn[2]; r1[1] = v1[1] * cs[2] + v1[0] * sn[2];
                        r1[2] = v1[2] * cs[3] - v1[3] * sn[3]; r1[3] = v1[3] * cs[3] + v1[2] * sn[3];
                        v0 = r0; v1 = r1; }
                    u32x4 w; w.x = cvt_pk_bf16(v0[0], v0[1]); w.y = cvt_pk_bf16(v0[2], v0[3]); w.z = cvt_pk_bf16(v1[0], v1[1]); w.w = cvt_pk_bf16(v1[2], v1[3]);
                    *(u32x4*)(Q + (size_t)row * 1536 + c) = w; } }
    }
};
struct EpiKV {
    static constexpr bool PERM = true;
    bf16_t* KF; bf16_t* VM; const float* rs;
    __device__ __forceinline__ void operator()(AccRef acc, const Unit& u, int wr, int wc, int fr, int fq) const {
        const int row0 = u.pm * BM + wr * 64 + fr, cw = wc * 32 + 8 * fq;
#pragma unroll
        for (int ai = 0; ai < 2; ++ai)
#pragma unroll
            for (int m = 0; m < 4; ++m) { const int row = row0 + ai * HALF + m * 16; const float s = rs[row];
#pragma unroll
                for (int bj = 0; bj < 2; ++bj) { const f32x4 v0 = acc[ai][bj][m][0] * s, v1 = acc[ai][bj][m][1] * s;
                    u32x4 w; w.x = cvt_pk_bf16(v0[0], v0[1]); w.y = cvt_pk_bf16(v0[2], v0[3]); w.z = cvt_pk_bf16(v1[0], v1[1]); w.w = cvt_pk_bf16(v1[2], v1[3]);
                    bf16_t* dst = bj == 0 ? KF + (size_t)row * 1536 + u.pn * 192 + cw : VM + (size_t)row * 1024 + u.pn * 128 + cw;
                    *(u32x4*)dst = w; } }
    }
};
__device__ __forceinline__ float em1f_(float x) {
    const float pl = x * (1.f + x * (0.5f + x * (0.16666667f + x * (0.041666668f + x * 0.0083333338f))));
    return fabsf(x) < 0.25f ? pl : __expf(x) - 1.f;
}
struct EpiGate {
    static constexpr bool PERM = false;
    const bf16_t* UC; const float* ba; const float* bx; const float* spt; float* Gm; f32x2* AGA; f32x2* AGB;
    __device__ __forceinline__ void operator()(AccRef acc, const Unit& u, int wr, int wc, int fr, int fq) const {
        const int dir = u.pn >> 3, h = u.pn & 7, row0 = u.pm * BM + wr * 64 + fr;
        const int bb_ = (u.pm >= 17) ? 1 : 0;
#pragma unroll
        for (int n = 0; n < 2; ++n) { const int cc = wc * 32 + 16 * n + 4 * fq, ch = h * 128 + cc;
            const f32x4 b_a = *(const f32x4*)(ba + dir * 1024 + ch), b_x = *(const f32x4*)(bx + dir * 1024 + ch), sp = *(const f32x4*)(spt + dir * 1024 + ch);
#pragma unroll
            for (int ai = 0; ai < 2; ++ai)
#pragma unroll
                for (int mp = 0; mp < 2; ++mp) {
                    f32x4 Ac[2], Bc[2];
#pragma unroll
                    for (int mm = 0; mm < 2; ++mm) { const int m = 2 * mp + mm; const int row = row0 + ai * HALF + m * 16;
                        const u32x2 uw = *(const u32x2*)(UC + (size_t)row * 1024 + ch);
                        const float uu[4] = {bflo(uw.x), bfhi(uw.x), bflo(uw.y), bfhi(uw.y)};
                        f32x4 av, bv;
#pragma unroll
                        for (int j = 0; j < 4; ++j) { const float r = sigmoidf_(acc[ai][0][m][n][j] + b_a[j]), ig = sigmoidf_(acc[ai][1][m][n][j] + b_x[j]);
                            const float la = r * sp[j], a = __expf(la), x2 = 2.f * la; av[j] = a;
                            const float pl = x2 * (1.f + x2 * (0.5f + x2 * (0.16666667f + x2 * (0.041666668f + x2 * 0.0083333338f))));
                            bv[j] = sqrtf(x2 > -0.25f ? -pl : 1.f - a * a) * (ig * uu[j]); }
                        float* o = Gm + (size_t)row * 4096 + u.pn * 256 + cc;
                        *(f32x4*)o = av; *(f32x4*)(o + 128) = bv;
#define GSTEP(SFT) { const bool first = (((fr >> SFT) & 1) == 0) != (dir != 0);     \
                            _Pragma("unroll") for (int j = 0; j < 4; ++j) { const float pa = lane_xor16<SFT>(av[j]), pb = lane_xor16<SFT>(bv[j]); \
                                const float nb = first ? pa * bv[j] + pb : av[j] * pb + bv[j]; av[j] = av[j] * pa; bv[j] = nb; } }
                        GSTEP(0) GSTEP(1) GSTEP(2) GSTEP(3)
#undef GSTEP
                        Ac[mm] = av; Bc[mm] = bv; }
                    f32x4 At, Bt;
                    if (dir == 0) { At = Ac[0] * Ac[1]; Bt = Ac[1] * Bc[0] + Bc[1]; } else { At = Ac[0] * Ac[1]; Bt = Ac[0] * Bc[1] + Bc[0]; }
                    if (fr == 0) { const int c32 = (u.pm - 17 * bb_) * 8 + ai * 4 + wr * 2 + mp; const size_t o = ((size_t)(dir * 2 + bb_) * 136 + c32) * 512 + (ch >> 1);
                        AGA[o] = (f32x2){At[0], At[1]}; AGA[o + 1] = (f32x2){At[2], At[3]}; AGB[o] = (f32x2){Bt[0], Bt[1]}; AGB[o + 1] = (f32x2){Bt[2], Bt[3]}; }
                    asm volatile("" ::: "memory"); } }
    }
};
template <int KI> struct EpiMerge {
    static constexpr bool PERM = true;
    const bf16_t* P; const bf16_t* Yin; bf16_t* Yout;
    __device__ __forceinline__ void operator()(AccRef acc, const Unit& u, int wr, int wc, int fr, int fq) const {
        const int row0 = u.pm * BM + wr * 64 + fr;
#pragma unroll
        for (int ai = 0; ai < 2; ++ai)
#pragma unroll
            for (int m = 0; m < 4; ++m) { const int row = row0 + ai * HALF + m * 16;
#pragma unroll
                for (int bj = 0; bj < 2; ++bj) { const int c = u.pn * BM + bj * HALF + wc * 32 + 8 * fq; const size_t o = (size_t)row * DM + c;
                    const u32x4 gw = *(const u32x4*)(P + (size_t)row * INP + C_G0 + KI * 2048 + c);
                    u32x4 yw = {0u, 0u, 0u, 0u}; if (KI > 0) yw = *(const u32x4*)(Yin + o);
                    f32x4 g0 = {bflo(gw.x), bfhi(gw.x), bflo(gw.y), bfhi(gw.y)}, g1 = {bflo(gw.z), bfhi(gw.z), bflo(gw.w), bfhi(gw.w)};
                    f32x4 v0, v1;
#pragma unroll
                    for (int j = 0; j < 4; ++j) { v0[j] = sigmoidf_(g0[j]) * acc[ai][bj][m][0][j]; v1[j] = sigmoidf_(g1[j]) * acc[ai][bj][m][1][j]; }
                    if (KI > 0) { v0 += (f32x4){bflo(yw.x), bfhi(yw.x), bflo(yw.y), bfhi(yw.y)}; v1 += (f32x4){bflo(yw.z), bfhi(yw.z), bflo(yw.w), bfhi(yw.w)}; }
                    u32x4 w; w.x = cvt_pk_bf16(v0[0], v0[1]); w.y = cvt_pk_bf16(v0[2], v0[3]); w.z = cvt_pk_bf16(v1[0], v1[1]); w.w = cvt_pk_bf16(v1[2], v1[3]); *(u32x4*)(Yout + o) = w; } }
    }
};
struct EpiMergeS {
    static constexpr bool PERM = true;
    const bf16_t* P; float* S;
    __device__ __forceinline__ void operator()(AccRef acc, const Unit& u, int wr, int wc, int fr, int fq) const {
        const int k = u.pn >> 3, row0 = u.pm * BM + wr * 64 + fr, crow0 = (u.pm ? 256 : 0) + wr * 64 + fr;
#pragma unroll
        for (int ai = 0; ai < 2; ++ai)
#pragma unroll
            for (int m = 0; m < 4; ++m) { const int row = row0 + ai * HALF + m * 16, crow = crow0 + ai * HALF + m * 16;
#pragma unroll
                for (int bj = 0; bj < 2; ++bj) { const int c = (u.pn & 7) * BM + bj * HALF + wc * 32 + 8 * fq;
                    const u32x4 gw = *(const u32x4*)(P + (size_t)row * INP + C_G0 + k * 2048 + c);
                    f32x4 g0 = {bflo(gw.x), bfhi(gw.x), bflo(gw.y), bfhi(gw.y)}, g1 = {bflo(gw.z), bfhi(gw.z), bflo(gw.w), bfhi(gw.w)};
                    f32x4 v0, v1;
#pragma unroll
                    for (int j = 0; j < 4; ++j) { v0[j] = sigmoidf_(g0[j]) * acc[ai][bj][m][0][j]; v1[j] = sigmoidf_(g1[j]) * acc[ai][bj][m][1][j]; }
                    float* o = S + ((size_t)k * 512 + crow) * DM + c;
                    *(f32x4*)o = v0; *(f32x4*)(o + 4) = v1; } }
    }
};
struct EpiF32 {
    static constexpr bool PERM = false;
    float* C; int ldc;
    __device__ __forceinline__ void operator()(AccRef acc, const Unit& u, int wr, int wc, int fr, int fq) const {
        const int row0 = u.pm * BM + wr * 64 + fr, col0 = u.pn * BM + wc * 32 + 4 * fq;
#pragma unroll
        for (int ai = 0; ai < 2; ++ai)
#pragma unroll
            for (int m = 0; m < 4; ++m) { float* rowp = C + (size_t)(row0 + ai * HALF + m * 16) * ldc + col0;
#pragma unroll
                for (int bj = 0; bj < 2; ++bj)
#pragma unroll
                    for (int n = 0; n < 2; ++n) *(f32x4*)(rowp + bj * HALF + n * 16) = acc[ai][bj][m][n]; }
    }
};
struct EpiF32S {
    static constexpr bool PERM = false;
    float* C;
    __device__ __forceinline__ void operator()(AccRef acc, const Unit& u, int wr, int wc, int fr, int fq) const {
        const int row0 = (u.pm ? 256 : 0) + wr * 64 + fr, col0 = (u.pn & 7) * BM + wc * 32 + 4 * fq; float* base = C + (size_t)(u.pn >> 3) * 512 * DM;
#pragma unroll
        for (int ai = 0; ai < 2; ++ai)
#pragma unroll
            for (int m = 0; m < 4; ++m) { float* rowp = base + (size_t)(row0 + ai * HALF + m * 16) * DM + col0;
#pragma unroll
                for (int bj = 0; bj < 2; ++bj)
#pragma unroll
                    for (int n = 0; n < 2; ++n) *(f32x4*)(rowp + bj * HALF + n * 16) = acc[ai][bj][m][n]; }
    }
};
struct EpiSwiGLU {
    static constexpr bool PERM = true;
    bf16_t* O;
    __device__ __forceinline__ void operator()(AccRef acc, const Unit& u, int wr, int wc, int fr, int fq) const {
        const int row0 = u.pm * BM + wr * 64 + fr, col0 = u.pn * 128 + wc * 32 + 8 * fq;
#pragma unroll
        for (int ai = 0; ai < 2; ++ai)
#pragma unroll
            for (int m = 0; m < 4; ++m) { f32x4 v0, v1;
#pragma unroll
                for (int j = 0; j < 4; ++j) { const float g0 = acc[ai][0][m][0][j], g1 = acc[ai][0][m][1][j];
                    v0[j] = g0 * sigmoidf_(g0) * acc[ai][1][m][0][j]; v1[j] = g1 * sigmoidf_(g1) * acc[ai][1][m][1][j]; }
                u32x4 w; w.x = cvt_pk_bf16(v0[0], v0[1]); w.y = cvt_pk_bf16(v0[2], v0[3]); w.z = cvt_pk_bf16(v1[0], v1[1]); w.w = cvt_pk_bf16(v1[2], v1[3]);
                *(u32x4*)(O + (size_t)(row0 + ai * HALF + m * 16) * FF + col0) = w; }
    }
};
}

namespace att {
constexpr int SHM_V = 16384, OFF_V = 0, OFF_K = 32768, OFF_WS = 32768 + 49152, OFF_RPB = OFF_WS + 2048, RPB_PAD = 64, OFF_Q = OFF_RPB + 2560;
#define SBAR() __builtin_amdgcn_sched_barrier(0)
__device__ __forceinline__ int crow(int r, int hi) { return (r & 3) + 8 * (r >> 2) + 4 * hi; }
template <int DQK> __device__ __forceinline__ int kswz(int row, int colB) { return row * (DQK * 2) + (colB ^ ((row & 7) << 4)); }

template <int DQK> struct Scl;
template <> struct Scl<192> { static constexpr float SCALE = 0.07216878364870322f; };
template <> struct Scl<128> { static constexpr float SCALE = 0.08838834764831845f; };
constexpr float THR = 8.f;

struct NaMask { bool lat, rowok; int bidx, cs; };

template <int DQK, int MODE>
__device__ __forceinline__ void partialSM(f32x16& p0, f32x16& p1, float& m_reg, float& mn, float& alpha, const NaMask& mk, const LAS float* rpbT, int hi) {
    constexpr float SCALE = Scl<DQK>::SCALE, C = SCALE * 1.4426950408889634f;
    if (MODE == 1) { if (mk.lat) {
        int csv = mk.cs - 4 * hi; asm volatile("" : "+v"(csv));
#pragma unroll
        for (int r = 0; r < 16; ++r) { const int ko = (r & 3) + 8 * (r >> 2); const int kc = ko;
            const float b0 = rpbT[mk.bidx + ko], b1 = rpbT[mk.bidx + 32 + ko];
            const bool ok0 = mk.rowok && (unsigned)(kc - csv) < 16u, ok1 = mk.rowok && (unsigned)(kc + 32 - csv) < 16u;
            p0[r] = ok0 ? p0[r] + b0 * (1.f / SCALE) : -3.0e38f; p1[r] = ok1 ? p1[r] + b1 * (1.f / SCALE) : -3.0e38f; } } }
    float pmax = p0[0];
#pragma unroll
    for (int r = 1; r < 16; ++r) pmax = fmaxf(pmax, p0[r]);
#pragma unroll
    for (int r = 0; r < 16; ++r) pmax = fmaxf(pmax, p1[r]);
    { auto rr = __builtin_amdgcn_permlane32_swap(__float_as_uint(pmax), __float_as_uint(pmax), false, false);
      pmax = fmaxf(__uint_as_float(rr[0]), __uint_as_float(rr[1])); }
    if (__builtin_expect(__all(pmax - m_reg <= THR / SCALE), 1)) { mn = m_reg; alpha = 1.f; }
    else { mn = fmaxf(m_reg, pmax); alpha = __builtin_amdgcn_exp2f((m_reg - mn) * C); m_reg = mn; }
    const float mnC = -mn * C;
#pragma unroll
    for (int r = 0; r < 16; ++r) p0[r] = fmaf(p0[r], C, mnC);
#pragma unroll
    for (int r = 0; r < 16; ++r) p1[r] = fmaf(p1[r], C, mnC);
#pragma unroll
    for (int r = 0; r < 16; ++r) p0[r] = __builtin_amdgcn_exp2f(p0[r]);
}
__device__ __forceinline__ void finishSM(f32x16& p0, f32x16& p1, float alpha, float& l_reg, bf16x8& pa0, bf16x8& pa1, bf16x8& pa2, bf16x8& pa3) {
#pragma unroll
    for (int r = 0; r < 16; ++r) p1[r] = __builtin_amdgcn_exp2f(p1[r]);
    float ps = 0;
#pragma unroll
    for (int r = 0; r < 16; ++r) ps += p0[r];
#pragma unroll
    for (int r = 0; r < 16; ++r) ps += p1[r];
    { auto rr = __builtin_amdgcn_permlane32_swap(__float_as_uint(ps), __float_as_uint(ps), false, false);
      ps = __uint_as_float(rr[0]) + __uint_as_float(rr[1]); }
    l_reg = l_reg * alpha + ps;
#define PK4(P, BASE, OUT) do { unsigned a0 = cvt_pk_bf16(P[BASE + 0], P[BASE + 1]), a1 = cvt_pk_bf16(P[BASE + 2], P[BASE + 3]);   \
    unsigned b0 = cvt_pk_bf16(P[BASE + 4], P[BASE + 5]), b1 = cvt_pk_bf16(P[BASE + 6], P[BASE + 7]);                              \
    auto r0 = __builtin_amdgcn_permlane32_swap(a0, b0, false, false); auto r1 = __builtin_amdgcn_permlane32_swap(a1, b1, false, false); \
    u32x4 w = {r0[0], r1[0], r0[1], r1[1]}; OUT = *reinterpret_cast<bf16x8*>(&w); } while (0)
    PK4(p0, 0, pa0); PK4(p0, 8, pa1); PK4(p1, 0, pa2); PK4(p1, 8, pa3);
#undef PK4
}
template <int DQK>
__device__ __forceinline__ void qkt(f32x16& p0, f32x16& p1, const char* Ks, const bf16x8* qr, const char* qx, int r32, int hi) {
    p0 = f32x16{}; p1 = f32x16{};
#pragma unroll
    for (int d0 = 0; d0 < DQK / 16; ++d0) { const int cb = (d0 * 16 + hi * 8) * 2;
        const bf16x8 b0 = *reinterpret_cast<const bf16x8*>(Ks + kswz<DQK>(r32, cb));
        const bf16x8 b1 = *reinterpret_cast<const bf16x8*>(Ks + kswz<DQK>(32 + r32, cb));
        constexpr int NQR = 8; bf16x8 q; if (d0 < NQR) q = qr[d0]; else q = *reinterpret_cast<const bf16x8*>(qx + (d0 - NQR) * 1024);
        p0 = __builtin_amdgcn_mfma_f32_32x32x16_bf16(b0, q, p0, 0, 0, 0);
        p1 = __builtin_amdgcn_mfma_f32_32x32x16_bf16(b1, q, p1, 0, 0, 0); }
}
__device__ __forceinline__ int v_st(int k, int c) { const int kk = (k & ~0xC) | ((k & 4) << 1) | ((k & 8) >> 1); return ((kk >> 3) * 4 + (c >> 5)) * 512 + ((kk & 7) * 32 + (c & 31)) * 2; }
__device__ __forceinline__ int v_rd_base(int lane) { return ((lane & 3) << 3) | (((lane >> 2) & 3) << 6) | (((lane >> 4) & 1) << 5) | (((lane >> 5) & 1) << 8); }
constexpr int v_rd_off(int d0, int ks, int half) { return d0 * 512 + ks * 4096 + half * 2048; }
template <int OFF> __device__ __forceinline__ s16x4 tr_read(int vb) {
    s16x4 r; asm volatile("ds_read_b64_tr_b16 %0, %1 offset:%2" : "=&v"(r) : "v"(vb), "i"(OFF) : "memory"); return r;
}
template <int D0> __device__ __forceinline__ void pv_one(f32x16& od, int vb, bf16x8 pa0, bf16x8 pa1, bf16x8 pa2, bf16x8 pa3) {
    const s16x4 l0 = tr_read<v_rd_off(D0, 0, 0)>(vb), h0 = tr_read<v_rd_off(D0, 0, 1)>(vb), l1 = tr_read<v_rd_off(D0, 1, 0)>(vb), h1 = tr_read<v_rd_off(D0, 1, 1)>(vb);
    const s16x4 l2 = tr_read<v_rd_off(D0, 2, 0)>(vb), h2 = tr_read<v_rd_off(D0, 2, 1)>(vb), l3 = tr_read<v_rd_off(D0, 3, 0)>(vb), h3 = tr_read<v_rd_off(D0, 3, 1)>(vb);
    asm volatile("s_waitcnt lgkmcnt(0)" ::: "memory"); SBAR();
#define PK(L, H) (bf16x8){L[0], L[1], L[2], L[3], H[0], H[1], H[2], H[3]}
    od = __builtin_amdgcn_mfma_f32_32x32x16_bf16(pa0, PK(l0, h0), od, 0, 0, 0);
    od = __builtin_amdgcn_mfma_f32_32x32x16_bf16(pa1, PK(l1, h1), od, 0, 0, 0);
    od = __builtin_amdgcn_mfma_f32_32x32x16_bf16(pa2, PK(l2, h2), od, 0, 0, 0);
    od = __builtin_amdgcn_mfma_f32_32x32x16_bf16(pa3, PK(l3, h3), od, 0, 0, 0);
#undef PK
}
__device__ __forceinline__ void pv_d0(f32x16* o, int vb, bf16x8 pa0, bf16x8 pa1, bf16x8 pa2, bf16x8 pa3) {
    pv_one<0>(o[0], vb, pa0, pa1, pa2, pa3); pv_one<1>(o[1], vb, pa0, pa1, pa2, pa3); pv_one<2>(o[2], vb, pa0, pa1, pa2, pa3); pv_one<3>(o[3], vb, pa0, pa1, pa2, pa3);
}

template <int DQK, int MODE, int SDEPTH, bool EARLY = false>
__device__ __forceinline__ void attn_unit(const bf16_t* __restrict__ Qb, int ldq, const bf16_t* __restrict__ Kg, int ldk, const bf16_t* __restrict__ Vg, int ldv,
                                          bf16_t* __restrict__ Ob, int ldo, int NT, int base0, int n0, int base1, int R0, int lo, const float* __restrict__ rpb_h, char* lds) {
    const int tid = tid_opaque(), wid = tid >> 6, lane = tid & 63, r32 = lane & 31, hi = lane >> 5;
    constexpr int SHM_K = 64 * DQK * 2;
    char* V_lds = lds + OFF_V; char* K_lds = lds + OFF_K;
    float* ws = (float*)(lds + OFF_WS) + wid * 64; float* li_l = ws; float* al_l = ws + 32;
    const LAS float* rpbT = (const LAS float*)(LAS char*)(lds + OFF_RPB);
    __syncthreads();
    if (MODE == 1) { if (tid < 465) ((float*)(lds + OFF_RPB))[RPB_PAD + tid] = rpb_h[tid]; }
    float m_reg = -1e30f, l_reg = 0; f32x16 o[4] = {}; bf16x8 qr[8];
    const bf16_t* Qw = Qb + (long)(wid * 32 + r32) * ldq + hi * 8;
    constexpr int NQR = 8;
    char* qx = lds + OFF_Q + wid * 7168 + lane * 16;
#pragma unroll
    for (int d0 = 0; d0 < NQR; ++d0) qr[d0] = *reinterpret_cast<const bf16x8*>(Qw + d0 * 16);
    if (DQK == 192) {
#pragma unroll
        for (int d0 = NQR; d0 < 12; ++d0) *reinterpret_cast<bf16x8*>(qx + (d0 - NQR) * 1024) = *reinterpret_cast<const bf16x8*>(Qw + d0 * 16);
    }
    const int sr = tid >> 4, sc = (tid & 15) * 8, vst0 = v_st(sr, sc), vst1 = v_st(32 + sr, sc);
    const int sr2 = tid >> 3, sc2 = 128 + (tid & 7) * 8;
    const int vb0 = (int)(uintptr_t)(LAS char*)V_lds + v_rd_base(lane);
    const int qrow = R0 + (wid >> 1), qc = (wid & 1) * 32 + r32;
    const int rs_ = min(max(qrow - 4, 0), 56), cs_ = min(max(qc - 8, 0), 48);
    auto mk_of = [&](int j) { NaMask mk; mk.lat = (MODE == 1) && (j >= 4); const int kr = lo + j - 4; mk.rowok = (kr >= rs_) && (kr < rs_ + 8);
        const int dr = min(max(kr - qrow + 7, 0), 14); mk.bidx = RPB_PAD + dr * 31 + 15 - qc + 4 * hi; mk.cs = cs_; return mk; };
    auto krow = [&](int j) -> long { return (j < n0) ? (long)base0 + 64 * j : (long)base1 + 64 * (j - n0); };
    struct { bf16x8 vs0, vs1, ks0, ks1, ks2; } sr_[SDEPTH];
#define SLOAD(i, tj) do { const long kr__ = krow(tj); \
    sr_[i].vs0 = *reinterpret_cast<const bf16x8*>(Vg + (kr__ + sr) * ldv + sc); sr_[i].vs1 = *reinterpret_cast<const bf16x8*>(Vg + (kr__ + 32 + sr) * ldv + sc); \
    sr_[i].ks0 = *reinterpret_cast<const bf16x8*>(Kg + (kr__ + sr) * ldk + sc); sr_[i].ks1 = *reinterpret_cast<const bf16x8*>(Kg + (kr__ + 32 + sr) * ldk + sc); \
    if (DQK == 192) sr_[i].ks2 = *reinterpret_cast<const bf16x8*>(Kg + (kr__ + sr2) * ldk + sc2); } while (0)
#define SWRITE(b, i) do { *(bf16x8*)(V_lds + (b) * SHM_V + vst0) = sr_[i].vs0; *(bf16x8*)(V_lds + (b) * SHM_V + vst1) = sr_[i].vs1; \
    *(bf16x8*)(K_lds + (b) * SHM_K + kswz<DQK>(sr, sc * 2)) = sr_[i].ks0; *(bf16x8*)(K_lds + (b) * SHM_K + kswz<DQK>(32 + sr, sc * 2)) = sr_[i].ks1; \
    if (DQK == 192) *(bf16x8*)(K_lds + (b) * SHM_K + kswz<DQK>(sr2, sc2 * 2)) = sr_[i].ks2; } while (0)
#define SWAIT() do { if constexpr (SDEPTH == 2) { if constexpr (DQK == 192) asm volatile("s_waitcnt vmcnt(5)" ::: "memory"); else asm volatile("s_waitcnt vmcnt(4)" ::: "memory"); } \
    else asm volatile("s_waitcnt vmcnt(0)" ::: "memory"); } while (0)
#define RESC(a) do { if (__any((a) < 1.f)) { if (hi == 0) al_l[r32] = (a); asm volatile("s_waitcnt lgkmcnt(0)" ::: "memory"); \
    _Pragma("unroll") for (int d = 0; d < 4; ++d) _Pragma("unroll") for (int r = 0; r < 16; ++r) o[d][r] *= al_l[crow(r, hi)]; } } while (0)
    f32x16 pA0, pA1, pB0, pB1; float mnA, mnB, alA, alB; bf16x8 pa0, pa1, pa2, pa3;
    constexpr int SE = 0, SO = SDEPTH - 1;
    SLOAD(SE, 0); asm volatile("s_waitcnt vmcnt(0)" ::: "memory"); SWRITE(0, SE); __syncthreads();
    qkt<DQK>(pA0, pA1, K_lds, qr, qx, r32, hi); partialSM<DQK, MODE>(pA0, pA1, m_reg, mnA, alA, mk_of(0), rpbT, hi);
    SLOAD(SO, 1); if constexpr (SDEPTH == 2) { if (2 < NT) SLOAD(SE, 2); }
    SWAIT(); SWRITE(1, SO); if constexpr (EARLY) { if (2 < NT) SLOAD(SE, 2); } __syncthreads();
#pragma unroll 1
    for (int j = 1; j + 1 < NT; j += 2) {
        SBAR(); qkt<DQK>(pB0, pB1, K_lds + SHM_K, qr, qx, r32, hi);
        finishSM(pA0, pA1, alA, l_reg, pa0, pa1, pa2, pa3); SBAR();
        if constexpr (SDEPTH == 2) { SLOAD(SO, j + 2); } else if constexpr (!EARLY) { SLOAD(SE, j + 1); } SBAR();
        pv_d0(o, vb0, pa0, pa1, pa2, pa3); partialSM<DQK, MODE>(pB0, pB1, m_reg, mnB, alB, mk_of(j), rpbT, hi);
        __syncthreads(); SWAIT(); SWRITE(0, SE);
        if constexpr (EARLY) { SLOAD(SO, j + 2); }
        RESC(alB); __syncthreads();
        SBAR(); qkt<DQK>(pA0, pA1, K_lds, qr, qx, r32, hi);
        finishSM(pB0, pB1, alB, l_reg, pa0, pa1, pa2, pa3); SBAR();
        if constexpr (SDEPTH == 2) { if (j + 3 < NT) SLOAD(SE, j + 3); } else if constexpr (!EARLY) { SLOAD(SO, j + 2); } SBAR();
        pv_d0(o, vb0 + SHM_V, pa0, pa1, pa2, pa3); partialSM<DQK, MODE>(pA0, pA1, m_reg, mnA, alA, mk_of(j + 1), rpbT, hi);
        __syncthreads(); SWAIT(); SWRITE(1, SO);
        if constexpr (EARLY) { if (j + 3 < NT) SLOAD(SE, j + 3); }
        RESC(alA); __syncthreads();
    }
    SBAR(); qkt<DQK>(pB0, pB1, K_lds + SHM_K, qr, qx, r32, hi);
    finishSM(pA0, pA1, alA, l_reg, pa0, pa1, pa2, pa3); SBAR();
    pv_d0(o, vb0, pa0, pa1, pa2, pa3); partialSM<DQK, MODE>(pB0, pB1, m_reg, mnB, alB, mk_of(NT - 1), rpbT, hi);
    __syncthreads(); RESC(alB);
    finishSM(pB0, pB1, alB, l_reg, pa0, pa1, pa2, pa3); SBAR();
    pv_d0(o, vb0 + SHM_V, pa0, pa1, pa2, pa3);
    if (hi == 0) li_l[r32] = l_reg; asm volatile("s_waitcnt lgkmcnt(0)" ::: "memory");
    float rli[16];
#pragma unroll
    for (int r = 0; r < 16; ++r) rli[r] = __builtin_amdgcn_rcpf(li_l[crow(r, hi)]);
    bf16_t* Ow = Ob + (long)(wid * 32) * ldo;
#pragma unroll
    for (int r = 0; r < 16; ++r) { const int orow = crow(r, hi);
#pragma unroll
        for (int d0 = 0; d0 < 4; ++d0) Ow[(long)orow * ldo + d0 * 32 + r32] = (bf16_t)f2bf(o[d0][r] * rli[r]); }
#undef SLOAD
#undef SWRITE
#undef SWAIT
#undef RESC
}
}

template <class RM>
__device__ __forceinline__ void tr_item(const float* __restrict__ W, int ldw, int k0, int n0, const float* __restrict__ gk, bf16_t* __restrict__ WT, int ldt, int kdst0, RM rm, float* scr, int lane) {
    float v[32];
#pragma unroll
    for (int i = 0; i < 32; ++i) v[i] = W[(size_t)(k0 + 2 * i + (lane >> 5)) * ldw + n0 + (lane & 31)];
    if (gk) {
#pragma unroll
        for (int i = 0; i < 32; ++i) v[i] *= gk[k0 + 2 * i + (lane >> 5)]; }
#pragma unroll
    for (int i = 0; i < 32; ++i) scr[(2 * i + (lane >> 5)) * 33 + (lane & 31)] = v[i];
    LDS_WAIT(); asm volatile("" ::: "memory");
    const int c = lane & 7;
#pragma unroll
    for (int j = 0; j < 4; ++j) { const int n = (lane >> 3) + 8 * j; const float* s = scr + (8 * c) * 33 + n;
        u32x4 o; o.x = pk2(s[0 * 33], s[1 * 33]); o.y = pk2(s[2 * 33], s[3 * 33]); o.z = pk2(s[4 * 33], s[5 * 33]); o.w = pk2(s[6 * 33], s[7 * 33]);
        *(u32x4*)(WT + (size_t)rm(n0 + n) * ldt + kdst0 + k0 + 8 * c) = o; }
    LDS_WAIT(); asm volatile("" ::: "memory");
}
struct RmId { int off; __device__ int operator()(int n) const { return n + off; } };
struct RmQ { __device__ int operator()(int n) const { const int head = n / 192, d = n % 192; if (d < 128) return n; const int p = d - 128, axis = p >> 5, w = p & 31, par = w >> 4, f = w & 15; return head * 192 + 128 + axis * 32 + 2 * f + par; } };
struct RmGU { int up; __device__ int operator()(int n) const { return (n >> 7) * 256 + up * 128 + (n & 127); } };

constexpr int I_IN = 32 * 378, I_Q = 8 * 48, I_KV = 4 * 64, I_G = 256, I_M = 16 * 64, I_OUT = 32 * 64, I_GU = 32 * 176, I_DN = 88 * 64;
constexpr int I_LAYER = I_IN + I_Q + I_KV + I_G + 3 * I_M + I_OUT + 2 * I_GU + I_DN;
constexpr int R_M0 = I_IN + I_Q + I_KV + I_G, N_DEF1 = 3 * I_M + I_OUT;
constexpr int DJ_DN = N_DEF1, DJ_GU = DJ_DN + I_DN, DJ_IN = DJ_GU + 2 * I_GU, DJ_END = DJ_IN + I_IN;
__device__ __forceinline__ void convert_item(const Params& p, int l, int r, float* scr, int lane) {
    unsigned char* wl = p.ws + WS_W + (size_t)l * W_LAYER;
    if (r < I_IN) { tr_item(p.in[10] + (size_t)l * DM * INW, INW, (r / 378) * 64, (r % 378) * 32, nullptr, (bf16_t*)(wl + W_IN), DM, 0, RmId{0}, scr, lane); return; } r -= I_IN;
    if (r < I_Q) { tr_item(p.in[12] + (size_t)l * 512 * 1536, 1536, (r / 48) * 64, (r % 48) * 32, p.in[11] + l * 512, (bf16_t*)(wl + W_Q), 512, 0, RmQ{}, scr, lane); return; } r -= I_Q;
    if (r < I_KV) { tr_item(p.in[14] + (size_t)l * 256 * 2048, 2048, (r / 64) * 64, (r % 64) * 32, p.in[13] + l * 256, (bf16_t*)(wl + W_KV), 256, 0, RmId{0}, scr, lane); return; } r -= I_KV;
    if (r < I_G) { const int sub = r & 7, blk = r >> 3, h = blk & 7, dir = (blk >> 3) & 1, gate = blk >> 4;
        const float* W = (gate ? p.in[20] : p.in[18]) + ((size_t)(l * 2 + dir) * 8 + h) * 128 * 128;
        tr_item(W, 128, (sub >> 2) * 64, (sub & 3) * 32, nullptr, (bf16_t*)(wl + W_G), 256, (h & 1) * 128, RmId{(dir * 8 + h) * 256 + gate * 128}, scr, lane); return; } r -= I_G;
    if (r < 3 * I_M) { const int k = r / I_M, rr = r % I_M; const float* W = (k == 0 ? p.in[15] : k == 1 ? p.in[23] : p.in[25]) + (size_t)l * 1024 * DM;
        tr_item(W, DM, (rr / 64) * 64, (rr % 64) * 32, nullptr, (bf16_t*)(wl + W_MRG) + (size_t)k * DM * 1024, 1024, 0, RmId{0}, scr, lane); return; } r -= 3 * I_M;
    if (r < I_OUT) { tr_item(p.in[26] + (size_t)l * DM * DM, DM, (r / 64) * 64, (r % 64) * 32, nullptr, (bf16_t*)(wl + W_OUT), DM, 0, RmId{0}, scr, lane); return; } r -= I_OUT;
    if (r < 2 * I_GU) { const int up = r / I_GU, rr = r % I_GU; const float* W = (up ? p.in[28] : p.in[27]) + (size_t)l * DM * FF;
        tr_item(W, FF, (rr / 176) * 64, (rr % 176) * 32, nullptr, (bf16_t*)(wl + W_GU), DM, 0, RmGU{up}, scr, lane); return; } r -= 2 * I_GU;
    tr_item(p.in[29] + (size_t)l * FF * DM, DM, (r / 64) * 64, (r % 64) * 32, nullptr, (bf16_t*)(wl + W_DN), FF, 0, RmId{0}, scr, lane);
}
__device__ __forceinline__ void convert_deferred(const Params& p, char* lds, int first, int j0, int j1) {
    const int G = gridDim.x; if (G != 256) first = 0;
    if ((int)blockIdx.x < first) return;
    const int tid = tid_opaque(), lane = tid & 63, wave = tid >> 6; float* scr = (float*)(lds + wave * 8448);
    const int gw = ((int)blockIdx.x - first) * NWAVES + wave, NGW = (G - first) * NWAVES;
    for (int j = j0 + gw; j < j1; j += NGW) {
        const int r = j < DJ_DN ? R_M0 + j : j < DJ_GU ? (I_LAYER - I_DN) + (j - DJ_DN) : j < DJ_IN ? R_M0 + N_DEF1 + (j - DJ_GU) : j - DJ_IN;
        convert_item(p, 1, r, scr, lane); }
    __syncthreads();
}
__device__ __forceinline__ void phase0(const Params& p, char* lds) {
    const int tid = tid_opaque(), lane = tid & 63, wave = tid >> 6;
    unsigned char* ws = p.ws;
    {
        float* s = (float*)lds; float* red = (float*)(lds + 24576);
        for (int i = tid; i < 3 * DM; i += NTHR) { const int v = i / DM, k = i % DM; const float x = (v < 2) ? p.in[1][v * DM + k] : p.in[3][k]; s[i] = x / (1.f + __expf(-x)); }
        __syncthreads();
        float* mods = (float*)(ws + WS_MODS);
        for (int grp = blockIdx.x; grp < 256; grp += gridDim.x) {
            const int l = grp >> 7, n0 = (grp & 127) * 96; const float* W = p.in[4] + (size_t)l * DM * 12288;
            const int kg = tid >> 5, cl = tid & 31; const bool act = cl < 24;
            f32x4 a0 = {0, 0, 0, 0}, a1 = a0, a2 = a0;
            if (act) {
#pragma unroll 8
                for (int i = 0; i < 128; ++i) { const int k = kg + 16 * i; const f32x4 w = *(const f32x4*)(W + (size_t)k * 12288 + n0 + 4 * cl);
                    a0 += w * s[k]; a1 += w * s[DM + k]; a2 += w * s[2 * DM + k]; }
                *(f32x4*)(red + (kg * 3 + 0) * 128 + 4 * cl) = a0; *(f32x4*)(red + (kg * 3 + 1) * 128 + 4 * cl) = a1; *(f32x4*)(red + (kg * 3 + 2) * 128 + 4 * cl) = a2; }
            __syncthreads();
            if (tid < 384) { const int v = tid >> 7, n = tid & 127; if (n < 96) { float acc = p.in[5][l * 12288 + n0 + n];
                for (int g2 = 0; g2 < 16; ++g2) acc += red[(g2 * 3 + v) * 128 + n];
                mods[(size_t)(l * 3 + v) * 12288 + n0 + n] = acc; } }
            __syncthreads();
        }
    }
    {
        float* cosT = (float*)(ws + WS_ROPE); float* sinT = cosT + SEQ * 32;
        for (int i = blockIdx.x * NTHR + tid; i < SEQ * 32; i += gridDim.x * NTHR) { const int t = i >> 5, j = i & 31, axis = j >> 4, f = j & 15;
            const float pos = (float)(axis ? (t & 63) : (t >> 6)); const float inv = powf(10000.0f, -(float)f / 16.0f); const float ang = pos * inv;
            cosT[i] = cosf(ang); sinT[i] = sinf(ang); }
    }
    { float* spt = (float*)(ws + WS_SPT); for (int i = blockIdx.x * NTHR + tid; i < 4096; i += gridDim.x * NTHR) spt[i] = -8.f * log1pf(expf(-p.in[22][i])); }
    float* scr = (float*)(lds + wave * 8448);
    const int gw = blockIdx.x * NWAVES + wave, NGW = gridDim.x * NWAVES;
    for (int it = gw; it < I_LAYER + (R_M0 - I_IN); it += NGW) {
        if (it < I_LAYER) convert_item(p, 0, it, scr, lane); else convert_item(p, 1, I_IN + (it - I_LAYER), scr, lane);
    }
    for (int i = blockIdx.x * NTHR + tid; i < 2 * 4096 * 16; i += gridDim.x * NTHR) { const int l = i >> 16, row = (i >> 4) & 4095, ch = i & 15; const int h = (row >> 8) & 7;
        bf16_t* dst = (bf16_t*)(ws + WS_W + (size_t)l * W_LAYER + W_G) + (size_t)row * 256 + ((h & 1) ^ 1) * 128 + ch * 8;
        *(u32x4*)dst = (u32x4){0u, 0u, 0u, 0u}; }
}

__device__ __forceinline__ float* xrow_ptr(const Params& p, int row) {
    const int b = row / RPB, rr = row % RPB;
    return rr < CTX ? (float*)(p.ws + WS_XC) + (size_t)(b * CTX + rr) * DM : p.out + (size_t)(b * SEQ + rr - CTX) * DM;
}
__device__ __forceinline__ void row_pass(const Params& p, int mode, const float* Z, const float* ZS, const float* gpost, const float* mods_res, int kg,
                                         const float* gpre, const float* mods_mod, int ksh, int ksc, bf16_t* H, bool skip_ctx) {
    const int tid = tid_opaque(), lane = tid & 63, wave = tid >> 6;
    const int gw = blockIdx.x * NWAVES + wave, NGW = gridDim.x * NWAVES;
    for (int row = gw; row < MROWS; row += NGW) {
        const int b = row / RPB, rr = row % RPB; const bool isctx = rr < CTX; const int v = isctx ? 2 : b;
        if (skip_ctx && isctx) continue;
        float* xr = xrow_ptr(p, row);
        f32x4 x[8];
        if (mode == 0) { const float* src = isctx ? p.in[2] + (size_t)(b * CTX + rr) * DM : p.in[0] + (size_t)(b * SEQ + rr - CTX) * DM;
#pragma unroll
            for (int j = 0; j < 8; ++j) x[j] = *(const f32x4*)(src + 4 * lane + 256 * j);
        } else {
            f32x4 z[8]; float ss = 0.f;
            const float* xs = (mode == 2) ? (isctx ? p.in[2] + (size_t)(b * CTX + rr) * DM : p.in[0] + (size_t)(b * SEQ + rr - CTX) * DM) : xr;
#pragma unroll
            for (int j = 0; j < 8; ++j) { x[j] = *(const f32x4*)(xs + 4 * lane + 256 * j);
                if (ZS && isctx) { const float* zp = ZS + (size_t)(b * CTX + rr) * DM + 4 * lane + 256 * j;
                    z[j] = (*(const f32x4*)zp + *(const f32x4*)(zp + (size_t)512 * DM)) + (*(const f32x4*)(zp + (size_t)1024 * DM) + *(const f32x4*)(zp + (size_t)1536 * DM)); }
                else { const u32x2 zw = *(const u32x2*)((const bf16_t*)Z + (size_t)row * DM + 4 * lane + 256 * j); z[j] = (f32x4){bflo(zw.x), bfhi(zw.x), bflo(zw.y), bfhi(zw.y)}; }
                ss += (z[j][0] * z[j][0] + z[j][1] * z[j][1]) + (z[j][2] * z[j][2] + z[j][3] * z[j][3]); }
            const float rs = rsqrtf(wave_sum(ss) * (1.f / DM) + EPS);
            const float* gt = mods_res + (size_t)v * 12288 + kg * DM;
#pragma unroll
            for (int j = 0; j < 8; ++j) { const f32x4 g = *(const f32x4*)(gt + 4 * lane + 256 * j), gp = *(const f32x4*)(gpost + 4 * lane + 256 * j);
                x[j] += g * (z[j] * rs * gp); }
        }
        if (mode != 0) {
#pragma unroll
            for (int j = 0; j < 8; ++j) *(f32x4*)(xr + 4 * lane + 256 * j) = x[j]; }
        if (gpre) {
            float ss = 0.f;
#pragma unroll
            for (int j = 0; j < 8; ++j) ss += (x[j][0] * x[j][0] + x[j][1] * x[j][1]) + (x[j][2] * x[j][2] + x[j][3] * x[j][3]);
            const float rs = rsqrtf(wave_sum(ss) * (1.f / DM) + EPS);
            const float* sh = mods_mod + (size_t)v * 12288 + ksh * DM; const float* sc = mods_mod + (size_t)v * 12288 + ksc * DM;
#pragma unroll
            for (int j = 0; j < 8; ++j) { const int c = 4 * lane + 256 * j; const f32x4 g = *(const f32x4*)(gpre + c), s1 = *(const f32x4*)(sc + c), s0 = *(const f32x4*)(sh + c);
                const f32x4 hv = x[j] * rs * g * (s1 + 1.f) + s0;
                u32x2 w; w.x = cvt_pk_bf16(hv[0], hv[1]); w.y = cvt_pk_bf16(hv[2], hv[3]);
                *(u32x2*)(H + (size_t)row * DM + c) = w; }
        }
    }
}

__device__ __forceinline__ void phase_p2(const Params& p, int l) {
    unsigned char* ws = p.ws; const bf16_t* P = (const bf16_t*)(ws + WS_R1);
    const int tid = tid_opaque(), lane = tid & 63, wave = tid >> 6;
    { bf16_t* UC = (bf16_t*)(ws + WS_R2 + R2_UC); const float* cw = p.in[16] + (size_t)l * 4 * 1024; const float* cb = p.in[17] + (size_t)l * 1024;
      for (int t = blockIdx.x * NTHR + tid; t < 512 * 256; t += gridDim.x * NTHR) { const int c4 = (t & 255) * 4, base = (t >> 8) * 17;
          const f32x4 w0 = *(const f32x4*)(cw + c4), w1 = *(const f32x4*)(cw + 1024 + c4), w2 = *(const f32x4*)(cw + 2048 + c4), w3 = *(const f32x4*)(cw + 3072 + c4), bs = *(const f32x4*)(cb + c4);
          const bf16_t* pu = P + C_U + c4;
#define LDU(r) ({ const int r_ = min(max((r), 0), MROWS - 1); const u32x2 q_ = *(const u32x2*)(pu + (size_t)r_ * INP); (f32x4){bflo(q_.x), bfhi(q_.x), bflo(q_.y), bfhi(q_.y)}; })
          f32x4 u0 = LDU(base - 2), u1 = LDU(base - 1), u2 = LDU(base), u3 = LDU(base + 1);
#pragma unroll
          for (int i = 0; i < 17; ++i) { const int row = base + i, rr = row % RPB; const int lo = rr < CTX ? 0 : CTX, hi = rr < CTX ? CTX : RPB;
              f32x4 un = u3; if (i < 16) un = LDU(row + 2);
              f32x4 acc = bs;
              if (rr - 2 >= lo) acc += w0 * u0;
              if (rr - 1 >= lo) acc += w1 * u1;
              acc += w2 * u2;
              if (rr + 1 < hi) acc += w3 * u3;
              u32x2 o; o.x = pk2(acc[0], acc[1]); o.y = pk2(acc[2], acc[3]);
              *(u32x2*)(UC + (size_t)row * 1024 + c4) = o;
              u0 = u1; u1 = u2; u2 = u3; u3 = un; }
#undef LDU
      } }
    { float* rsq = (float*)(ws + WS_RS); float* rskv = rsq + MROWS; bf16_t* KF = (bf16_t*)(ws + WS_R2 + R2_KF);
      const float* cosT = (const float*)(ws + WS_ROPE); const float* sinT = cosT + SEQ * 32;
      const int gw = blockIdx.x * NWAVES + wave, NGW = gridDim.x * NWAVES;
      for (int row = gw; row < MROWS; row += NGW) { const bf16_t* pr = P + (size_t)row * INP;
          const u32x4 qw = *(const u32x4*)(pr + 8 * lane);
          float s = bflo(qw.x) * bflo(qw.x) + bfhi(qw.x) * bfhi(qw.x) + bflo(qw.y) * bflo(qw.y) + bfhi(qw.y) * bfhi(qw.y) + bflo(qw.z) * bflo(qw.z) + bfhi(qw.z) * bfhi(qw.z) + bflo(qw.w) * bflo(qw.w) + bfhi(qw.w) * bfhi(qw.w);
          s = wave_sum(s);
          float s2 = 0.f;
          if (lane < 32) { const u32x4 kw = *(const u32x4*)(pr + C_KVA + 8 * lane);
              s2 = bflo(kw.x) * bflo(kw.x) + bfhi(kw.x) * bfhi(kw.x) + bflo(kw.y) * bflo(kw.y) + bfhi(kw.y) * bfhi(kw.y) + bflo(kw.z) * bflo(kw.z) + bfhi(kw.z) * bfhi(kw.z) + bflo(kw.w) * bflo(kw.w) + bfhi(kw.w) * bfhi(kw.w); }
          s2 = wave_sum(s2);
          if (lane == 0) { rsq[row] = rsqrtf(s * (1.f / 512.f) + EPS); rskv[row] = rsqrtf(s2 * (1.f / 256.f) + EPS); }
          if (lane < 32) { const int axis = lane >> 4, f = lane & 15; const int rr = row % RPB;
              float x1 = bf2f(pr[C_KR + axis * 32 + f]), x2 = bf2f(pr[C_KR + axis * 32 + 16 + f]);
              if (rr >= CTX) { const int t = rr - CTX; const float cs = cosT[t * 32 + axis * 16 + f], sn = sinT[t * 32 + axis * 16 + f];
                  const float y1 = x1 * cs - x2 * sn, y2 = x2 * cs + x1 * sn; x1 = y1; x2 = y2; }
              const unsigned w = pk2(x1, x2);
#pragma unroll
              for (int h = 0; h < 8; ++h) *(unsigned*)(KF + (size_t)row * 1536 + h * 192 + 128 + axis * 32 + 2 * f) = w; } } }
}

constexpr int NCH = 136;
__device__ __forceinline__ size_t gcol(int d, int ch) { return (size_t)((d * 8 + (ch >> 7)) * 256 + (ch & 127)); }
__device__ __forceinline__ void scan_s1(const Params& p) {
    unsigned char* ws = p.ws; const float* Gm = (const float*)(ws + WS_R3); f32x2* AGA = (f32x2*)(ws + WS_AGG); f32x2* AGB = AGA + (size_t)4 * NCH * 512;
    const int tid = tid_opaque();
    for (int it = blockIdx.x; it < 4 * NCH; it += gridDim.x) { const int d = it & 1, c = (it >> 1) % NCH, b = it / (2 * NCH);
        const float* gp = Gm + (size_t)(b * RPB + 32 * c) * 4096 + gcol(d, 2 * tid);
        f32x2 A = {1.f, 1.f}, B = {0.f, 0.f};
#pragma unroll 8
        for (int s = 0; s < 32; ++s) { const int t = d ? 31 - s : s; const f32x2 a = *(const f32x2*)(gp + (size_t)t * 4096), bb = *(const f32x2*)(gp + (size_t)t * 4096 + 128); B = a * B + bb; A *= a; }
        const size_t o = ((size_t)(d * 2 + b) * NCH + c) * 512 + tid; AGA[o] = A; AGB[o] = B; }
}
__device__ __forceinline__ void scan_s2(const Params& p, char* lds) {
    unsigned char* ws = p.ws; const f32x2* AGA = (const f32x2*)(ws + WS_AGG); const f32x2* AGB = AGA + (size_t)4 * NCH * 512; f32x2* CAR = (f32x2*)(ws + WS_AGG) + (size_t)8 * NCH * 512;
    const int tid = tid_opaque(), w = tid >> 6, lane = tid & 63; f32x2* sa = (f32x2*)lds; f32x2* sb = sa + 512;
    for (int it = blockIdx.x; it < 32; it += gridDim.x) { const int db = it >> 3, d = db >> 1, cp = (it & 7) * 64 + lane;
        const size_t base = (size_t)db * NCH * 512 + cp;
        f32x2 A = {1.f, 1.f}, B = {0.f, 0.f};
#pragma unroll
        for (int i = 0; i < 17; ++i) { const int k = 17 * w + i, c = d == 0 ? k : (k < 8 ? 7 - k : NCH + 7 - k); const f32x2 a = AGA[base + (size_t)c * 512], bb = AGB[base + (size_t)c * 512]; B = a * B + bb; A *= a; }
        __syncthreads();
        sa[tid] = A; sb[tid] = B;
        __syncthreads();
        f32x2 h = {0.f, 0.f};
        for (int w2 = 0; w2 < w; ++w2) h = sa[w2 * 64 + lane] * h + sb[w2 * 64 + lane];
#pragma unroll
        for (int i = 0; i < 17; ++i) { const int k = 17 * w + i, c = d == 0 ? k : (k < 8 ? 7 - k : NCH + 7 - k); const f32x2 a = AGA[base + (size_t)c * 512], bb = AGB[base + (size_t)c * 512]; CAR[base + (size_t)c * 512] = h; h = a * h + bb; } }
}
__device__ __forceinline__ float gelu_tanh(float x) { const float u = 0.7978845608028654f * (x + 0.044715f * x * x * x); const float e = __expf(2.f * u); return x * (1.f - 1.f / (e + 1.f)); }
__device__ __forceinline__ void scan_s3_item(const Params& p, int it) {
    unsigned char* ws = p.ws; const float* Gm = (const float*)(ws + WS_R3); const f32x2* CAR = (const f32x2*)(ws + WS_AGG) + (size_t)8 * NCH * 512;
    const bf16_t* P = (const bf16_t*)(ws + WS_R1); bf16_t* RO = (bf16_t*)(ws + WS_MRN + 17 * MiB);
    const int tid = tid_opaque(); const int c = it % NCH, b = it / NCH, row0 = b * RPB + 32 * c;
    const float* gf = Gm + (size_t)row0 * 4096 + gcol(0, 2 * tid); const float* gb = Gm + (size_t)row0 * 4096 + gcol(1, 2 * tid);
    f32x2 hf[32]; f32x2 h = CAR[((size_t)(0 * 2 + b) * NCH + c) * 512 + tid];
#pragma unroll
    for (int t = 0; t < 32; ++t) { const f32x2 a = *(const f32x2*)(gf + (size_t)t * 4096), bb = *(const f32x2*)(gf + (size_t)t * 4096 + 128); h = a * h + bb; hf[t] = h; }
    h = CAR[((size_t)(1 * 2 + b) * NCH + c) * 512 + tid];
#pragma unroll
    for (int s = 0; s < 32; ++s) { const int t = 31 - s; const f32x2 a = *(const f32x2*)(gb + (size_t)t * 4096), bb = *(const f32x2*)(gb + (size_t)t * 4096 + 128); h = a * h + bb;
        const unsigned gw = *(const unsigned*)(P + (size_t)(row0 + t) * INP + C_RGG + 2 * tid);
        const f32x2 rec = hf[t] + h;
        *(unsigned*)(RO + (size_t)(row0 + t) * 1024 + 2 * tid) = pk2(gelu_tanh(bflo(gw)) * rec.x, gelu_tanh(bfhi(gw)) * rec.y); }
}

#define XB_TMO      128
#define XB_XCNT(j)  (256  + 64 * (j))
#define XB_XSUB(j)  (1280 + 64 * (j))
#define XB_XGEN(j)  (2304 + 64 * (j))
#define XB_TOP      3328
#define XB_TOPGEN   3392
#define XCD_BAR_WORDS 3456
#define XB_SPIN_CAP (1u << 18)
__device__ __forceinline__ unsigned xb_ld(unsigned* p)              { return __hip_atomic_load(p, __ATOMIC_RELAXED, __HIP_MEMORY_SCOPE_AGENT); }
__device__ __forceinline__ unsigned xb_add(unsigned* p, unsigned v) { return __hip_atomic_fetch_add(p, v, __ATOMIC_RELAXED, __HIP_MEMORY_SCOPE_AGENT); }
__device__ __forceinline__ unsigned xb_xcc_id() { return (unsigned)__builtin_amdgcn_s_getreg((3 << 11) | 20) & 0xFu; }
#define XB_SPIN(cond, bar) do { unsigned _sp = 0; while (cond) { __builtin_amdgcn_s_sleep(1); \
    if ((++_sp & 255u) == 0u) { if (xb_ld(&(bar)[XB_TMO])) break; if (_sp > XB_SPIN_CAP) { atomicAdd(&(bar)[XB_TMO], 1u); break; } } } } while (0)
struct XcdBarrier { unsigned* bar; unsigned x; volatile LAS unsigned* st; };
__device__ __forceinline__ XcdBarrier xcd_barrier_post(unsigned* bar, volatile LAS unsigned* st) {
    XcdBarrier b; b.bar = bar; b.x = xb_xcc_id(); b.st = st;
    if (threadIdx.x == 0) (void)xb_add(&bar[XB_XCNT(b.x)], 1u);
    return b;
}
__device__ __forceinline__ void xcd_barrier_complete(unsigned* bar, unsigned x, unsigned& nloc, unsigned& nx) {
    const unsigned G = gridDim.x * gridDim.y * gridDim.z;
    unsigned sum, cnt, mine, sp = 0u;
    for (;;) {
        sum = 0u; cnt = 0u; mine = 0u;
#pragma unroll
        for (unsigned j = 0; j < 16; ++j) { const unsigned c = xb_ld(&bar[XB_XCNT(j)]); sum += c; cnt += (c > 0u) ? 1u : 0u; mine = (j == x) ? c : mine; }
        if (sum == G) break;
        __builtin_amdgcn_s_sleep(1);
        if ((++sp & 255u) == 0u) { if (xb_ld(&bar[XB_TMO])) break; if (sp > XB_SPIN_CAP) { atomicAdd(&bar[XB_TMO], 1u); break; } }
    }
    nloc = mine > 0u ? mine : 1u; nx = cnt > 0u ? cnt : 1u;
}
__device__ __forceinline__ void xcd_barrier(const XcdBarrier& b) {
    asm volatile("s_waitcnt vmcnt(0)" ::: "memory");
    __syncthreads();
    if (threadIdx.x == 0) {
        unsigned* bar = b.bar;
        __builtin_amdgcn_s_waitcnt(0);
        unsigned nloc = b.st[0], nx = b.st[1];
        if (nloc == 0u) { xcd_barrier_complete(bar, b.x, nloc, nx); b.st[0] = nloc; b.st[1] = nx; }
        const unsigned old = xb_add(&bar[XB_XSUB(b.x)], 1u);
        const unsigned gen = old / nloc;
        if (old + 1u == (gen + 1u) * nloc) {
            __builtin_amdgcn_fence(__ATOMIC_RELEASE, "agent");
            asm volatile("s_waitcnt vmcnt(0)" ::: "memory");
            const unsigned og = xb_add(&bar[XB_TOP], 1u);
            const unsigned tg = og / nx;
            if (og + 1u == (tg + 1u) * nx) xb_add(&bar[XB_TOPGEN], 1u);
            else XB_SPIN(xb_ld(&bar[XB_TOPGEN]) == tg, bar);
            __builtin_amdgcn_fence(__ATOMIC_ACQUIRE, "agent");
            xb_add(&bar[XB_XGEN(b.x)], 1u);
            asm volatile("s_waitcnt vmcnt(0)" ::: "memory");
        } else {
            XB_SPIN(xb_ld(&bar[XB_XGEN(b.x)]) == gen, bar);
            __builtin_amdgcn_fence(__ATOMIC_ACQUIRE, "agent");
            asm volatile("s_waitcnt vmcnt(0)" ::: "memory");
        }
    }
    __syncthreads();
}

#ifndef PHMASK
#define PHMASK 0xFFFFFFFF
#endif
#define PH(k) ((PHMASK >> (k)) & 1u)
#ifndef DUPMASK
#define DUPMASK 0u
#endif
#define REP(k) for (int rep_ = 0; rep_ < 1 + (int)((DUPMASK >> (k)) & 1u); ++rep_)
__global__ void __launch_bounds__(NTHR, 2) fwd_megakernel(Params p) {
    extern __shared__ __attribute__((aligned(16))) unsigned char lds_raw[];
    cg::grid_group grid = cg::this_grid();
    char* lds = (char*)lds_raw; LAS unsigned char* ldsl = (LAS unsigned char*)lds_raw;
    unsigned char* ws = p.ws;
    const int G = gridDim.x, bid = blockIdx.x;
    float* mods = (float*)(ws + WS_MODS);
    bf16_t* Pm = (bf16_t*)(ws + WS_R1); bf16_t* ACT = (bf16_t*)(ws + WS_R1);
    bf16_t* UC = (bf16_t*)(ws + WS_R2 + R2_UC); bf16_t* Qm = (bf16_t*)(ws + WS_R2 + R2_Q); bf16_t* KF = (bf16_t*)(ws + WS_R2 + R2_KF); bf16_t* VM = (bf16_t*)(ws + WS_R2 + R2_VM);
    bf16_t* H = (bf16_t*)(ws + WS_R2 + R2_H); bf16_t* Y = (bf16_t*)(ws + WS_R2 + R2_Y);
    float* ABa = (float*)(ws + WS_R3); float* ABb = ABa + (size_t)2 * MROWS * 1024; float* YT0 = (float*)(ws + WS_R3); float* YT1 = (float*)(ws + WS_R3 + 68 * MiB); float* Z = YT0;
    bf16_t* MO = (bf16_t*)(ws + WS_MRN); bf16_t* NO = (bf16_t*)(ws + WS_MRN + 34 * MiB);
    float* rsq = (float*)(ws + WS_RS); float* rskv = rsq + MROWS; const float* cosT = (const float*)(ws + WS_ROPE); const float* sinT = cosT + SEQ * 32;

    if (threadIdx.x < 2) ((volatile LAS unsigned*)(ldsl + LDS_BYTES - 64))[threadIdx.x] = 0u;
    __syncthreads();
    const XcdBarrier xbar = xcd_barrier_post((unsigned*)(ws + WS_BAR), (volatile LAS unsigned*)(ldsl + LDS_BYTES - 64));
    REP(0) { phase0(p, lds); __syncthreads(); }
    if (p.ws == nullptr) grid.sync();
    REP(20) xcd_barrier(xbar);
    row_pass(p, 0, nullptr, nullptr, nullptr, nullptr, 0, p.in[6], mods, 0, 1, H, false);
    REP(20) xcd_barrier(xbar);

#pragma unroll 1
    for (int l = 0; l < 2; ++l) {
        const bool lastl = (l == 1);
        unsigned char* wl = ws + WS_W + (size_t)l * W_LAYER;
        const float* modl = mods + (size_t)l * 3 * 12288;
        float* ZSl = (float*)(ws + WS_ZS);
        REP(2) { pg8::Gemm g{H, (const bf16_t*)(wl + W_IN), DM, DM, DM, 0}; pg8::Order S; S.init(34, 48, G, bid, 0); pg8::EpiP E{Pm, INP}; pg8::gemm_phase(ldsl, g, S, E); }
        if (l == 0) convert_deferred(p, lds, 96, 0, DJ_GU);
        REP(20) xcd_barrier(xbar);
        REP(3) phase_p2(p, l);
        REP(20) xcd_barrier(xbar);
        REP(4) { pg8::Gemm g{Pm, (const bf16_t*)(wl + W_Q), INP, 512, 512, 0}; pg8::Order S; S.init(34, 6, G, bid, 0); pg8::EpiQ E{Qm, rsq, cosT, sinT}; pg8::gemm_phase(ldsl, g, S, E); }
        REP(5) { pg8::Gemm g{Pm + C_KVA, (const bf16_t*)(wl + W_KV), INP, 256, 256, 0}; pg8::Order S; S.init(34, 8, G, (bid + 16) % G, 0); pg8::EpiKV E{KF, VM, rskv};     pg8::gemm_phase(ldsl, g, S, E); }
        REP(6) { pg8::Gemm g{UC, (const bf16_t*)(wl + W_G), 1024, 256, 256, 1}; pg8::Order S; S.init(34, 16, G, (bid + 48) % G, 0); pg8::EpiGate E{UC, p.in[19] + (size_t)l * 2048, p.in[21] + (size_t)l * 2048, (const float*)(ws + WS_SPT) + (size_t)l * 2048, ABa, (f32x2*)(ws + WS_AGG), (f32x2*)(ws + WS_AGG) + (size_t)4 * 136 * 512}; pg8::gemm_phase(ldsl, g, S, E); }
        REP(20) xcd_barrier(xbar);
        REP(7) { scan_s2(p, lds); __syncthreads(); }
        REP(20) xcd_barrier(xbar);
        {
            REP(8) for (int u = bid; u < 256; u += G) {
                const int xcd = u & 7, idx = u >> 3, bh = 2 * xcd + (idx >> 4), qb = idx & 15, b = bh >> 3, h = bh & 7; const long r0 = (long)b * RPB;
                att::attn_unit<192, 0, 1>(Qm + (r0 + CTX + qb * 256) * 1536 + h * 192, 1536, KF + h * 192, 1536, VM + h * 128, 1024, MO + (r0 + CTX + qb * 256) * 1024 + h * 128, 1024,
                                          68, (int)r0, 68, 0, 0, 0, nullptr, lds);
            }
            const float* rpb = p.in[24] + (size_t)l * 8 * 465;
            REP(9) for (int u = bid; u < 256; u += G) {
                const int xcd = u & 7, idx = u >> 3, bh = 2 * xcd + (idx >> 4), rg = idx & 15, b = bh >> 3, h = bh & 7; const long r0 = (long)b * RPB; const int R0 = 4 * rg;
                int lo = min(max(R0 - 4, 0), 56), hi_ = min(max(R0 - 1, 0), 56) + 8; int nlat = hi_ - lo;
                if (nlat & 1) { if (hi_ < 64) ++nlat; else { --lo; ++nlat; } }
                att::attn_unit<128, 1, 1>(Pm + (r0 + CTX + R0 * 64) * INP + C_NQ + h * 128, INP, Pm + C_NK + h * 128, INP, Pm + C_NV + h * 128, INP,
                                          NO + (r0 + CTX + R0 * 64) * 1024 + h * 128, 1024, 4 + nlat, (int)r0, 4, (int)r0 + CTX + lo * 64, R0, lo, rpb + h * 465, lds);
            }
            { unsigned* qctr = (unsigned*)(ws + WS_BAR) + 3600 + 64 * l; volatile LAS unsigned* qslot = (volatile LAS unsigned*)(ldsl + LDS_BYTES - 48);
              const int nctx = lastl ? 0 : 32, ntot = nctx + 2 * NCH;
              for (;;) {
                  __syncthreads();
                  if (threadIdx.x == 0) *qslot = __hip_atomic_fetch_add(qctr, 1u, __ATOMIC_RELAXED, __HIP_MEMORY_SCOPE_AGENT);
                  __syncthreads();
                  const int it = (int)*qslot;
                  if (it >= ntot) break;
                  if (it < nctx) { const int u = it, b = (u >> 3) & 1, h = u & 7; const long r0 = (long)b * RPB;
                      if (u < 16) att::attn_unit<192, 0, 1>(Qm + r0 * 1536 + h * 192, 1536, KF + h * 192, 1536, VM + h * 128, 1024, MO + r0 * 1024 + h * 128, 1024, 4, (int)r0, 4, 0, 0, 0, nullptr, lds);
                      else att::attn_unit<128, 0, 1>(Pm + r0 * INP + C_NQ + h * 128, INP, Pm + C_NK + h * 128, INP, Pm + C_NV + h * 128, INP, NO + r0 * 1024 + h * 128, 1024, 4, (int)r0, 4, 0, 0, 0, nullptr, lds); }
                  else scan_s3_item(p, it - nctx);
              } }
        }
        REP(20) xcd_barrier(xbar);
        REP(12) { pg8::Order S; S.init(32, 8, G, bid, 1);
          { pg8::Gemm g{MO, (const bf16_t*)(wl + W_MRG), 1024, 1024, 1024, 0}; pg8::EpiMerge<0> E{Pm, nullptr, (bf16_t*)YT0}; pg8::gemm_phase(ldsl, g, S, E); }
          { pg8::Gemm g{MO + (size_t)MROWS * 1024, (const bf16_t*)(wl + W_MRG) + (size_t)DM * 1024, 1024, 1024, 1024, 0}; pg8::EpiMerge<1> E{Pm, (const bf16_t*)YT0, (bf16_t*)YT1}; pg8::gemm_phase(ldsl, g, S, E); }
          { pg8::Gemm g{MO + (size_t)2 * MROWS * 1024, (const bf16_t*)(wl + W_MRG) + (size_t)2 * DM * 1024, 1024, 1024, 1024, 0}; pg8::EpiMerge<2> E{Pm, (const bf16_t*)YT1, Y}; pg8::gemm_phase(ldsl, g, S, E); }
          if (!lastl) { pg8::Gemm g{MO, (const bf16_t*)(wl + W_MRG), 1024, 1024, 1024, 3}; pg8::Order S2; S2.init(2, 24, G, bid, 2); pg8::EpiMergeS E{Pm, ZSl}; pg8::gemm_phase(ldsl, g, S2, E); convert_deferred(p, lds, 48, DJ_GU, DJ_GU + 8192); } }
        REP(20) xcd_barrier(xbar);
        if (!lastl) { const int tid = tid_opaque(), lane = tid & 63, gw = bid * NWAVES + (tid >> 6);
            for (int cr = gw; cr < 512; cr += G * NWAVES) { const int row = (cr >> 8) * RPB + (cr & 255);
#pragma unroll
                for (int j = 0; j < 8; ++j) { const float* zp = ZSl + (size_t)cr * DM + 4 * lane + 256 * j;
                    const f32x4 v = *(const f32x4*)zp + *(const f32x4*)(zp + (size_t)512 * DM) + *(const f32x4*)(zp + (size_t)1024 * DM);
                    u32x2 w; w.x = cvt_pk_bf16(v[0], v[1]); w.y = cvt_pk_bf16(v[2], v[3]); *(u32x2*)(Y + (size_t)row * DM + 4 * lane + 256 * j) = w; } } }
        REP(13) { { pg8::Gemm g{Y, (const bf16_t*)(wl + W_OUT), DM, DM, DM, 0}; pg8::Order S; S.init(32, 8, G, bid, 1); pg8::EpiP E{(bf16_t*)Z, DM}; pg8::gemm_phase(ldsl, g, S, E); }
          if (!lastl) xcd_barrier(xbar);
          if (!lastl) { pg8::Gemm g{Y, (const bf16_t*)(wl + W_OUT), DM, DM, DM / 4, 2}; pg8::Order S; S.init(2, 32, G, bid, 2); pg8::EpiF32S E{ZSl}; pg8::gemm_phase(ldsl, g, S, E); convert_deferred(p, lds, 64, DJ_GU + 8192, DJ_IN); } }
        REP(20) xcd_barrier(xbar);
        row_pass(p, l == 0 ? 2 : 1, Z, lastl ? nullptr : ZSl, p.in[7] + (size_t)l * DM, modl, 2, p.in[8] + (size_t)l * DM, modl, 3, 4, H, lastl);
        REP(20) xcd_barrier(xbar);
        REP(15) { pg8::Gemm g{H, (const bf16_t*)(wl + W_GU), DM, DM, DM, 0}; pg8::Order S; S.init(lastl ? 32 : 34, 44, G, bid, lastl ? 1 : 0); pg8::EpiSwiGLU E{ACT}; pg8::gemm_phase(ldsl, g, S, E); if (!lastl) convert_deferred(p, lds, 216, DJ_IN, DJ_IN + 2880); }
        REP(20) xcd_barrier(xbar);
        REP(16) { { pg8::Gemm g{ACT, (const bf16_t*)(wl + W_DN), FF, FF, FF, 0}; pg8::Order S; S.init(32, 8, G, bid, 1); pg8::EpiP E{(bf16_t*)Z, DM}; pg8::gemm_phase(ldsl, g, S, E); }
          if (!lastl) { pg8::Gemm g{ACT, (const bf16_t*)(wl + W_DN), FF, FF, FF / 4, 2}; pg8::Order S; S.init(2, 32, G, bid, 2); pg8::EpiF32S E{ZSl}; pg8::gemm_phase(ldsl, g, S, E); convert_deferred(p, lds, 64, DJ_IN + 2880, DJ_END); } }
        REP(20) xcd_barrier(xbar);
        { if (!lastl) row_pass(p, 1, Z, ZSl, p.in[9] + (size_t)l * DM, modl, 5, p.in[6] + (size_t)(l + 1) * DM, mods + (size_t)(l + 1) * 3 * 12288, 0, 1, H, false);
        else row_pass(p, 1, Z, nullptr, p.in[9] + (size_t)l * DM, modl, 5, nullptr, nullptr, 0, 0, nullptr, true); }
        if (!lastl) REP(20) xcd_barrier(xbar);
    }
}

extern "C" void kernel_launch(void* const* d_in, const int* in_sizes, int n_in, void* d_out, int out_size, void* d_ws, size_t ws_size, hipStream_t stream) {
    static int grid_blocks = 0;
    if (grid_blocks == 0) {
        if (n_in != 30 || ws_size < WS_END) { fprintf(stderr, "kernel_launch: unexpected n_in %d or workspace %zu < %zu\n", n_in, ws_size, (size_t)WS_END); grid_blocks = -1; return; }
        int dev = 0, cus = 0, per_cu = 0;
        hipGetDevice(&dev);
        hipDeviceGetAttribute(&cus, hipDeviceAttributeMultiprocessorCount, dev);
        hipFuncSetAttribute((const void*)fwd_megakernel, hipFuncAttributeMaxDynamicSharedMemorySize, LDS_BYTES);
        hipOccupancyMaxActiveBlocksPerMultiprocessor(&per_cu, (const void*)fwd_megakernel, NTHR, LDS_BYTES);
        if (per_cu < 1) per_cu = 1;
        grid_blocks = cus * per_cu;
        if (grid_blocks > 256) grid_blocks = 256;
    }
    if (grid_blocks < 0) return;
    Params p{};
    for (int i = 0; i < 30; ++i) p.in[i] = (const float*)d_in[i];
    p.out = (float*)d_out; p.ws = (unsigned char*)d_ws;
    (void)hipMemsetAsync((unsigned char*)d_ws + WS_BAR, 0, BAR_BYTES, stream);
    void* args[] = {&p};
    hipError_t e = hipLaunchCooperativeKernel((const void*)fwd_megakernel, dim3(grid_blocks), dim3(NTHR), args, LDS_BYTES, stream);
    if (e != hipSuccess) fprintf(stderr, "cooperative launch failed: %s (grid %d)\n", hipGetErrorString(e), grid_blocks);
}
```

```cpp
#define DUPMASK 0x0u
#include <hip/hip_runtime.h>
#include <hip/hip_cooperative_groups.h>
#include <cstdio>
#include <cstdint>
namespace cg = cooperative_groups;

#define LAS __attribute__((address_space(3)))
typedef unsigned short bf16_t;
typedef short bf16x8 __attribute__((ext_vector_type(8)));
typedef short s16x4 __attribute__((ext_vector_type(4)));
typedef float f32x2 __attribute__((ext_vector_type(2)));
typedef float f32x4 __attribute__((ext_vector_type(4)));
typedef float f32x16 __attribute__((ext_vector_type(16)));
typedef unsigned u32x2 __attribute__((ext_vector_type(2)));
typedef unsigned u32x4 __attribute__((ext_vector_type(4)));

constexpr int DM = 2048, SEQ = 4096, CTX = 256, RPB = 4352  , MROWS = 8704, INW = 12096, INP = 12288, FF = 5632;
constexpr int C_KVA = 512, C_KR = 768, C_U = 832, C_RGG = 1856, C_NQ = 2880, C_NK = 3904, C_NV = 4928, C_G0 = 5952;
constexpr float EPS = 1e-6f;
constexpr int NTHR = 512, NWAVES = 8;
constexpr int LDS_BYTES = 147456;

constexpr size_t MiB = (size_t)1 << 20;
constexpr size_t WS_MODS = 0, WS_SPT = 512 * 1024, WS_BAR = 768 * 1024, BAR_BYTES = 16384, WS_ROPE = 1 * MiB, WS_RS = 2 * MiB, WS_AGG = 3 * MiB, WS_XC = 10 * MiB, WS_W = 14 * MiB;
constexpr size_t W_IN = 0, W_Q = 48 * MiB, W_KV = W_Q + 1536 * 1024, W_G = W_KV + 1 * MiB, W_MRG = W_G + 2 * MiB, W_OUT = W_MRG + 12 * MiB, W_GU = W_OUT + 8 * MiB,
                 W_DN = W_GU + 44 * MiB, W_LAYER = W_DN + 22 * MiB;
constexpr size_t WS_R1 = WS_W + 2 * W_LAYER;
constexpr size_t WS_R2 = WS_R1 + 204 * MiB;
constexpr size_t R2_UC = 0, R2_Q = 17 * MiB, R2_KF = R2_Q + 8704 * 1536 * 2, R2_VM = 68 * MiB, R2_H = 0, R2_Y = 34 * MiB;
constexpr size_t WS_R3 = WS_R2 + 85 * MiB;
constexpr size_t WS_MRN = WS_R3 + 136 * MiB;
constexpr size_t WS_ZS = WS_R2 + R2_VM;
constexpr size_t WS_XB = WS_MRN + 51 * MiB;
constexpr size_t WS_END = WS_XB + 34 * MiB;

struct Params { const float* in[30]; float* out; unsigned char* ws; };

__device__ __forceinline__ unsigned f2bf(float f) { unsigned u = __builtin_bit_cast(unsigned, f); return (u + 0x7fffu + ((u >> 16) & 1u)) >> 16; }
__device__ __forceinline__ unsigned pk2(float lo, float hi) { return f2bf(lo) | (f2bf(hi) << 16); }
__device__ __forceinline__ float bf2f(unsigned b) { return __builtin_bit_cast(float, b << 16); }
__device__ __forceinline__ float bflo(unsigned w) { return __builtin_bit_cast(float, w << 16); }
__device__ __forceinline__ float bfhi(unsigned w) { return __builtin_bit_cast(float, w & 0xffff0000u); }
__device__ __forceinline__ unsigned cvt_pk_bf16(float lo, float hi) { unsigned r; asm volatile("v_cvt_pk_bf16_f32 %0, %1, %2" : "=v"(r) : "v"(lo), "v"(hi)); return r; }
__device__ __forceinline__ float sigmoidf_(float x) { return 1.f / (1.f + __expf(-x)); }
__device__ __forceinline__ int tid_opaque() { int t = threadIdx.x; asm volatile("" : "+v"(t)); return t; }
__device__ __forceinline__ float wave_sum(float v) {
#pragma unroll
    for (int o = 1; o < 64; o <<= 1) v += __shfl_xor(v, o);
    return v;
}
template <int CTRL> __device__ __forceinline__ float dppf(float v) { return __builtin_bit_cast(float, __builtin_amdgcn_update_dpp(0, __builtin_bit_cast(int, v), CTRL, 0xF, 0xF, true)); }
template <int SFT> __device__ __forceinline__ float lane_xor16(float v) {
    if constexpr (SFT == 0) return dppf<0xB1>(v);
    else if constexpr (SFT == 1) return dppf<0x4E>(v);
    else if constexpr (SFT == 2) return dppf<0x1B>(dppf<0x141>(v));
    else return dppf<0x141>(dppf<0x140>(v));
}
#define LDS_WAIT() asm volatile("s_waitcnt lgkmcnt(0)" ::: "memory")

namespace pg8 {
constexpr int BM = 256, BK = 64, HALF = 128, HTB = HALF * BK * 2, NXCD = 8, WGM = 8;
__device__ __forceinline__ int lds_byte(int r, int c) { const int st = (r >> 4) * 2 + (c >> 5), rr = r & 15, cc = c & 31, ob = rr * 64 + cc * 2; return st * 1024 + (ob ^ (((ob >> 9) & 1) << 5)); }
__device__ __forceinline__ void stage_rc(int b, int& R, int& C) { const int st = b / 1024, sb = b % 1024, swz = sb ^ (((sb >> 9) & 1) << 5); R = (st >> 1) * 16 + swz / 64; C = (st & 1) * 32 + (swz % 64) / 2; }
__device__ __forceinline__ int perm32(int rho) { const int n = rho >> 4, i = rho & 15; return 8 * (i >> 2) + 4 * n + (i & 3); }

struct Unit { int pm, pn; };
struct Gemm { const bf16_t* A; const bf16_t* Bt; int lda, ldb, K, amode; };
struct Order {
    int nM, nN, nwg, G, c, mskip, tri;
    __device__ void init(int nM_, int nN_, int G_, int c_, int mskip_, int tri_ = 0) { nM = nM_; nN = nN_; nwg = nM * nN; G = G_; c = c_; mskip = mskip_; tri = tri_; }
    __device__ bool next(int i0, Unit& u) const {
        const int i = tri ? i0 / 3 : i0, ksub = tri ? i0 - 3 * i : 0;
        const long L = (long)i * G + c; if (L >= nwg) return false;
        int wgid = (int)L; { const int q = nwg / NXCD, r = nwg % NXCD, xcd = wgid % NXCD, off = wgid / NXCD; wgid = (xcd < r ? xcd * (q + 1) : r * (q + 1) + (xcd - r) * q) + off; }
        const int nig = WGM * nN, gid = wgid / nig, fm = gid * WGM, gsz = (nM - fm) < WGM ? (nM - fm) : WGM;
        u.pm = fm + ((wgid % nig) % gsz); u.pn = (wgid % nig) / gsz;
        if (mskip == 1) u.pm += 1 + (u.pm >= 16 ? 1 : 0);
        else if (mskip == 2) u.pm *= 17;
        u.pn += 8 * ksub;
        return true;
    }
};

template <class Epi>
__device__ __forceinline__ void gemm_phase(LAS unsigned char* lds, const Gemm g, const Order& S, const Epi& E) {
    const int tid = tid_opaque(), wid = __builtin_amdgcn_readfirstlane(tid >> 6), lane = tid & 63, wr = wid >> 2, wc = wid & 3, fr = lane & 15, fq = lane >> 4;
    const int K = g.K, nt = K / BK;
    unsigned voffA[2], voffB[2];
#pragma unroll
    for (int i = 0; i < 2; ++i) { int R, C; stage_rc(tid * 16 + i * 8192, R, C); const int Rb = Epi::PERM ? ((R & ~31) + perm32(R & 31)) : R;
        voffA[i] = (unsigned)(R * g.lda + C) * 2u; voffB[i] = (unsigned)(Rb * g.ldb + C) * 2u; }
    const size_t kstep = (size_t)(BK * 2);
    const size_t hstepA = (size_t)HALF * g.lda * 2, tstepA = 2 * hstepA;
    const size_t hstepB = (size_t)HALF * g.ldb * 2, tstepB = 2 * hstepB;
    const unsigned ldsw = (unsigned)wid * 1024u;
    const int aoff = lds_byte(wr * 64 + fr, fq * 8), boff = lds_byte(wc * 32 + fr, fq * 8);
#define PG8_SA(b, h) (((b) * 2 + (h)) * HTB)
#define PG8_SB(b, h) ((4 + (b) * 2 + (h)) * HTB)
#define PG8_STAGE(bufoff, gbase, voff) do { _Pragma("unroll") for (int _i = 0; _i < 2; ++_i) \
        __builtin_amdgcn_global_load_lds((const unsigned*)((const char*)(gbase) + (voff)[_i]), (LAS unsigned*)(lds + (bufoff) + ldsw + _i * 8192), 16, 0, 0); } while (0)
#define PG8_LDA(dst, b, h) do { _Pragma("unroll") for (int m = 0; m < 4; ++m) _Pragma("unroll") for (int k = 0; k < 2; ++k) dst[m][k] = *(const LAS bf16x8*)(lds + PG8_SA(b, h) + aoff + m * 2048 + k * 1024); } while (0)
#define PG8_LDB(dst, b, h) do { _Pragma("unroll") for (int n = 0; n < 2; ++n) _Pragma("unroll") for (int k = 0; k < 2; ++k) dst[n][k] = *(const LAS bf16x8*)(lds + PG8_SB(b, h) + boff + n * 2048 + k * 1024); } while (0)
#define PG8_MMA(ai, bj, At, Bt) do { __builtin_amdgcn_s_setprio(1); _Pragma("unroll") for (int m = 0; m < 4; ++m) _Pragma("unroll") for (int n = 0; n < 2; ++n) _Pragma("unroll") for (int k = 0; k < 2; ++k) \
        acc[ai][bj][m][n] = __builtin_amdgcn_mfma_f32_16x16x32_bf16(Bt[n][k], At[m][k], acc[ai][bj][m][n], 0, 0, 0); __builtin_amdgcn_s_setprio(0); } while (0)
#define PG8_WAIT_V(n) asm volatile("s_waitcnt vmcnt(" #n ")" ::: "memory")
#define PG8_WAIT_L(n) asm volatile("s_waitcnt lgkmcnt(" #n ")" ::: "memory")
#define PG8_BAR __builtin_amdgcn_s_barrier()
#define PG8_SCHED __builtin_amdgcn_sched_barrier(0)
#define PG8_APTR(u) ((const char*)g.A + (size_t)(u).pm * tstepA + (g.amode == 1 ? (size_t)((((u).pn & 7) >> 1) * 512) : g.amode == 2 ? (size_t)((u).pn >> 3) * (size_t)K * 2 : g.amode == 3 ? (size_t)((u).pn >> 3) * ((size_t)MROWS * 1024 * 2) : (size_t)0))
#define PG8_BPTR(u) ((const char*)g.Bt + (g.amode == 2 ? (size_t)((u).pn & 7) * tstepB + (size_t)((u).pn >> 3) * (size_t)K * 2 : g.amode == 3 ? (size_t)((u).pn & 7) * tstepB + (size_t)((u).pn >> 3) * ((size_t)DM * 1024 * 2) : (size_t)(u).pn * tstepB))
    Unit cur, nxt; int ui = 0;
    if (!S.next(0, cur)) return;
    f32x4 acc[2][2][4][2];
#pragma unroll
    for (int a = 0; a < 2; ++a)
#pragma unroll
        for (int b = 0; b < 2; ++b)
#pragma unroll
            for (int m = 0; m < 4; ++m)
#pragma unroll
                for (int n = 0; n < 2; ++n) acc[a][b][m][n] = (f32x4){0.f, 0.f, 0.f, 0.f};
    bf16x8 At[4][2], B0[2][2], B1[2][2];
    const char* cA = PG8_APTR(cur); const char* cB = PG8_BPTR(cur);
    PG8_STAGE(PG8_SB(0, 0), cB, voffB); PG8_STAGE(PG8_SB(0, 1), cB + hstepB, voffB); PG8_STAGE(PG8_SA(0, 0), cA, voffA); PG8_STAGE(PG8_SA(0, 1), cA + hstepA, voffA);
    if (wr == 1) PG8_BAR;
    PG8_WAIT_V(2); PG8_BAR;
    PG8_STAGE(PG8_SB(1, 0), cB + kstep, voffB); PG8_STAGE(PG8_SA(1, 0), cA + kstep, voffA); PG8_STAGE(PG8_SB(1, 1), cB + hstepB + kstep, voffB);
    PG8_WAIT_V(6); PG8_BAR;
    for (;;) {
        const bool has_next = S.next(ui + 1, nxt);
        const char* nA = has_next ? PG8_APTR(nxt) : cA; const char* nB = has_next ? PG8_BPTR(nxt) : cB;
#pragma unroll 1
        for (int t = 0; t < nt; t += 2) {
            const bool last = (t == nt - 2);
            const char* a1 = cA + (size_t)(t + 1) * kstep;
            const char* a2 = last ? nA : cA + (size_t)(t + 2) * kstep; const char* b2 = last ? nB : cB + (size_t)(t + 2) * kstep;
            const char* a3 = a2 + kstep; const char* b3 = b2 + kstep;
            PG8_LDB(B0, 0, 0); PG8_LDB(B1, 0, 1); PG8_SCHED; PG8_LDA(At, 0, 0); PG8_STAGE(PG8_SA(1, 1), a1 + hstepA, voffA);
            PG8_WAIT_V(8); PG8_WAIT_L(0); PG8_BAR; PG8_MMA(0, 0, At, B0); PG8_MMA(0, 1, At, B1); PG8_BAR; PG8_SCHED;
            PG8_LDA(At, 0, 1); PG8_STAGE(PG8_SB(0, 0), b2, voffB); PG8_STAGE(PG8_SB(0, 1), b2 + hstepB, voffB); PG8_STAGE(PG8_SA(0, 0), a2, voffA);
            PG8_WAIT_V(8); PG8_WAIT_L(0); PG8_BAR; PG8_MMA(1, 0, At, B0); PG8_MMA(1, 1, At, B1); PG8_BAR; PG8_SCHED;
            PG8_LDB(B0, 1, 0); PG8_LDB(B1, 1, 1); PG8_SCHED; PG8_LDA(At, 1, 0); PG8_STAGE(PG8_SA(0, 1), a2 + hstepA, voffA);
            PG8_WAIT_V(8); PG8_WAIT_L(0); PG8_BAR; PG8_MMA(0, 0, At, B0); PG8_MMA(0, 1, At, B1); PG8_BAR; PG8_SCHED;
            PG8_LDA(At, 1, 1); PG8_STAGE(PG8_SB(1, 0), b3, voffB); PG8_STAGE(PG8_SB(1, 1), b3 + hstepB, voffB); PG8_STAGE(PG8_SA(1, 0), a3, voffA);
            PG8_WAIT_V(8); PG8_WAIT_L(0); PG8_BAR; PG8_MMA(1, 0, At, B0); PG8_MMA(1, 1, At, B1); PG8_BAR; PG8_SCHED;
        }
        if (wr == 0) PG8_BAR;
        E(acc, cur, wr, wc, fr, fq);
        if (!has_next) break;
#pragma unroll
        for (int a = 0; a < 2; ++a)
#pragma unroll
            for (int b = 0; b < 2; ++b)
#pragma unroll
                for (int m = 0; m < 4; ++m)
#pragma unroll
                    for (int n = 0; n < 2; ++n) acc[a][b][m][n] = (f32x4){0.f, 0.f, 0.f, 0.f};
        cur = nxt; cA = nA; cB = nB; ++ui;
        if (wr == 1) PG8_BAR;
    }
    PG8_WAIT_V(0);
    PG8_BAR;
#undef PG8_SA
#undef PG8_SB
#undef PG8_STAGE
#undef PG8_LDA
#undef PG8_LDB
#undef PG8_MMA
#undef PG8_WAIT_V
#undef PG8_WAIT_L
#undef PG8_BAR
#undef PG8_SCHED
#undef PG8_APTR
#undef PG8_BPTR
}

typedef const f32x4 (&AccRef)[2][2][4][2];

struct EpiP {
    static constexpr bool PERM = true;
    bf16_t* O; int ldc;
    __device__ __forceinline__ void operator()(AccRef acc, const Unit& u, int wr, int wc, int fr, int fq) const {
        const int row0 = u.pm * BM + wr * 64 + fr, col0 = u.pn * BM + wc * 32 + 8 * fq;
#pragma unroll
        for (int ai = 0; ai < 2; ++ai)
#pragma unroll
            for (int m = 0; m < 4; ++m) { bf16_t* rowp = O + (size_t)(row0 + ai * HALF + m * 16) * ldc + col0;
#pragma unroll
                for (int bj = 0; bj < 2; ++bj) { const f32x4 v0 = acc[ai][bj][m][0], v1 = acc[ai][bj][m][1];
                    u32x4 w; w.x = cvt_pk_bf16(v0[0], v0[1]); w.y = cvt_pk_bf16(v0[2], v0[3]); w.z = cvt_pk_bf16(v1[0], v1[1]); w.w = cvt_pk_bf16(v1[2], v1[3]);
                    *(u32x4*)(rowp + bj * HALF) = w; } }
    }
};
struct EpiQ {
    static constexpr bool PERM = true;
    bf16_t* Q; const float* rs; const float* cosT; const float* sinT;
    __device__ __forceinline__ void operator()(AccRef acc, const Unit& u, int wr, int wc, int fr, int fq) const {
        const int row0 = u.pm * BM + wr * 64 + fr;
#pragma unroll
        for (int ai = 0; ai < 2; ++ai)
#pragma unroll
            for (int m = 0; m < 4; ++m) { const int row = row0 + ai * HALF + m * 16; const int rr = row % RPB; const bool lat = rr >= CTX; const int t = rr - CTX; const float s = rs[row];
#pragma unroll
                for (int bj = 0; bj < 2; ++bj) { const int c = u.pn * BM + bj * HALF + wc * 32 + 8 * fq; const int d = c % 192;
                    f32x4 v0 = acc[ai][bj][m][0] * s, v1 = acc[ai][bj][m][1] * s;
                    if (d >= 128 && lat) { const int p = d - 128, axis = p >> 5, f0 = (p & 31) >> 1; const size_t ti = (size_t)t * 32 + axis * 16 + f0;
                        const f32x4 cs = *(const f32x4*)(cosT + ti), sn = *(const f32x4*)(sinT + ti);
                        f32x4 r0, r1;
                        r0[0] = v0[0] * cs[0] - v0[1] * sn[0]; r0[1] = v0[1] * cs[0] + v0[0] * sn[0];
                        r0[2] = v0[2] * cs[1] - v0[3] * sn[1]; r0[3] = v0[3] * cs[1] + v0[2] * sn[1];
                        r1[0] = v1[0] * cs[2] - v1[1] * sn[2]; r1[1] = v1[1] * cs[2] + v1[0] * sn[2];
                        r1[2] = v1[2] * cs[3] - v1[3] * sn[3]; r1[3] = v1[3] * cs[3] + v1[2] * sn[3];
                        v0 = r0; v1 = r1; }
                    u32x4 w; w.x = cvt_pk_bf16(v0[0], v0[1]); w.y = cvt_pk_bf16(v0[2], v0[3]); w.z = cvt_pk_bf16(v1[0], v1[1]); w.w = cvt_pk_bf16(v1[2], v1[3]);
                    *(u32x4*)(Q + (size_t)row * 1536 + c) = w; } }
    }
};
struct EpiKV {
    static constexpr bool PERM = true;
    bf16_t* KF; bf16_t* VM; const float* rs;
    __device__ __forceinline__ void operator()(AccRef acc, const Unit& u, int wr, int wc, int fr, int fq) const {
        const int row0 = u.pm * BM + wr * 64 + fr, cw = wc * 32 + 8 * fq;
#pragma unroll
        for (int ai = 0; ai < 2; ++ai)
#pragma unroll
            for (int m = 0; m < 4; ++m) { const int row = row0 + ai * HALF + m * 16; const float s = rs[row];
#pragma unroll
                for (int bj = 0; bj < 2; ++bj) { const f32x4 v0 = acc[ai][bj][m][0] * s, v1 = acc[ai][bj][m][1] * s;
                    u32x4 w; w.x = cvt_pk_bf16(v0[0], v0[1]); w.y = cvt_pk_bf16(v0[2], v0[3]); w.z = cvt_pk_bf16(v1[0], v1[1]); w.w = cvt_pk_bf16(v1[2], v1[3]);
                    bf16_t* dst = bj == 0 ? KF + (size_t)row * 1536 + u.pn * 192 + cw : VM + (size_t)row * 1024 + u.pn * 128 + cw;
                    *(u32x4*)dst = w; } }
    }
};
__device__ __forceinline__ float em1f_(float x) {
    const float pl = x * (1.f + x * (0.5f + x * (0.16666667f + x * (0.041666668f + x * 0.0083333338f))));
    return fabsf(x) < 0.25f ? pl : __expf(x) - 1.f;
}
struct EpiGate {
    static constexpr bool PERM = false;
    const bf16_t* UC; const float* ba; const float* bx; const float* spt; float* Gm; f32x2* AGA; f32x2* AGB;
    __device__ __forceinline__ void operator()(AccRef acc, const Unit& u, int wr, int wc, int fr, int fq) const {
        const int dir = u.pn >> 3, h = u.pn & 7, row0 = u.pm * BM + wr * 64 + fr;
        const int bb_ = (u.pm >= 17) ? 1 : 0;
#pragma unroll
        for (int n = 0; n < 2; ++n) { const int cc = wc * 32 + 16 * n + 4 * fq, ch = h * 128 + cc;
            const f32x4 b_a = *(const f32x4*)(ba + dir * 1024 + ch), b_x = *(const f32x4*)(bx + dir * 1024 + ch), sp = *(const f32x4*)(spt + dir * 1024 + ch);
#pragma unroll
            for (int ai = 0; ai < 2; ++ai)
#pragma unroll
                for (int mp = 0; mp < 2; ++mp) {
                    f32x4 Ac[2], Bc[2];
#pragma unroll
                    for (int mm = 0; mm < 2; ++mm) { const int m = 2 * mp + mm; const int row = row0 + ai * HALF + m * 16;
                        const u32x2 uw = *(const u32x2*)(UC + (size_t)row * 1024 + ch);
                        const float uu[4] = {bflo(uw.x), bfhi(uw.x), bflo(uw.y), bfhi(uw.y)};
                        f32x4 av, bv;
#pragma unroll
                        for (int j = 0; j < 4; ++j) { const float r = sigmoidf_(acc[ai][0][m][n][j] + b_a[j]), ig = sigmoidf_(acc[ai][1][m][n][j] + b_x[j]);
                            const float la = r * sp[j], a = __expf(la), x2 = 2.f * la; av[j] = a;
                            const float pl = x2 * (1.f + x2 * (0.5f + x2 * (0.16666667f + x2 * (0.041666668f + x2 * 0.0083333338f))));
                            bv[j] = sqrtf(x2 > -0.25f ? -pl : 1.f - a * a) * (ig * uu[j]); }
                        float* o = Gm + (size_t)row * 4096 + u.pn * 256 + cc;
                        *(f32x4*)o = av; *(f32x4*)(o + 128) = bv;
#define GSTEP(SFT) { const bool first = (((fr >> SFT) & 1) == 0) != (dir != 0);     \
                            _Pragma("unroll") for (int j = 0; j < 4; ++j) { const float pa = lane_xor16<SFT>(av[j]), pb = lane_xor16<SFT>(bv[j]); \
                                const float nb = first ? pa * bv[j] + pb : av[j] * pb + bv[j]; av[j] = av[j] * pa; bv[j] = nb; } }
                        GSTEP(0) GSTEP(1) GSTEP(2) GSTEP(3)
#undef GSTEP
                        Ac[mm] = av; Bc[mm] = bv; }
                    f32x4 At, Bt;
                    if (dir == 0) { At = Ac[0] * Ac[1]; Bt = Ac[1] * Bc[0] + Bc[1]; } else { At = Ac[0] * Ac[1]; Bt = Ac[0] * Bc[1] + Bc[0]; }
                    if (fr == 0) { const int c32 = (u.pm - 17 * bb_) * 8 + ai * 4 + wr * 2 + mp; const size_t o = ((size_t)(dir * 2 + bb_) * 136 + c32) * 512 + (ch >> 1);
                        AGA[o] = (f32x2){At[0], At[1]}; AGA[o + 1] = (f32x2){At[2], At[3]}; AGB[o] = (f32x2){Bt[0], Bt[1]}; AGB[o + 1] = (f32x2){Bt[2], Bt[3]}; }
                    asm volatile("" ::: "memory"); } }
    }
};
template <int KI> struct EpiMerge {
    static constexpr bool PERM = true;
    const bf16_t* P; const bf16_t* Yin; bf16_t* Yout;
    __device__ __forceinline__ void operator()(AccRef acc, const Unit& u, int wr, int wc, int fr, int fq) const {
        const int row0 = u.pm * BM + wr * 64 + fr;
#pragma unroll
        for (int ai = 0; ai < 2; ++ai)
#pragma unroll
            for (int m = 0; m < 4; ++m) { const int row = row0 + ai * HALF + m * 16;
#pragma unroll
                for (int bj = 0; bj < 2; ++bj) { const int c = u.pn * BM + bj * HALF + wc * 32 + 8 * fq; const size_t o = (size_t)row * DM + c;
                    const u32x4 gw = *(const u32x4*)(P + (size_t)row * INP + C_G0 + KI * 2048 + c);
                    u32x4 yw = {0u, 0u, 0u, 0u}; if (KI > 0) yw = *(const u32x4*)(Yin + o);
                    f32x4 g0 = {bflo(gw.x), bfhi(gw.x), bflo(gw.y), bfhi(gw.y)}, g1 = {bflo(gw.z), bfhi(gw.z), bflo(gw.w), bfhi(gw.w)};
                    f32x4 v0, v1;
#pragma unroll
                    for (int j = 0; j < 4; ++j) { v0[j] = sigmoidf_(g0[j]) * acc[ai][bj][m][0][j]; v1[j] = sigmoidf_(g1[j]) * acc[ai][bj][m][1][j]; }
                    if (KI > 0) { v0 += (f32x4){bflo(yw.x), bfhi(yw.x), bflo(yw.y), bfhi(yw.y)}; v1 += (f32x4){bflo(yw.z), bfhi(yw.z), bflo(yw.w), bfhi(yw.w)}; }
                    u32x4 w; w.x = cvt_pk_bf16(v0[0], v0[1]); w.y = cvt_pk_bf16(v0[2], v0[3]); w.z = cvt_pk_bf16(v1[0], v1[1]); w.w = cvt_pk_bf16(v1[2], v1[3]); *(u32x4*)(Yout + o) = w; } }
    }
};
struct EpiMergeS {
    static constexpr bool PERM = true;
    const bf16_t* P; float* S;
    __device__ __forceinline__ void operator()(AccRef acc, const Unit& u, int wr, int wc, int fr, int fq) const {
        const int k = u.pn >> 3, row0 = u.pm * BM + wr * 64 + fr, crow0 = (u.pm ? 256 : 0) + wr * 64 + fr;
#pragma unroll
        for (int ai = 0; ai < 2; ++ai)
#pragma unroll
            for (int m = 0; m < 4; ++m) { const int row = row0 + ai * HALF + m * 16, crow = crow0 + ai * HALF + m * 16;
#pragma unroll
                for (int bj = 0; bj < 2; ++bj) { const int c = (u.pn & 7) * BM + bj * HALF + wc * 32 + 8 * fq;
                    const u32x4 gw = *(const u32x4*)(P + (size_t)row * INP + C_G0 + k * 2048 + c);
                    f32x4 g0 = {bflo(gw.x), bfhi(gw.x), bflo(gw.y), bfhi(gw.y)}, g1 = {bflo(gw.z), bfhi(gw.z), bflo(gw.w), bfhi(gw.w)};
                    f32x4 v0, v1;
#pragma unroll
                    for (int j = 0; j < 4; ++j) { v0[j] = sigmoidf_(g0[j]) * acc[ai][bj][m][0][j]; v1[j] = sigmoidf_(g1[j]) * acc[ai][bj][m][1][j]; }
                    float* o = S + ((size_t)k * 512 + crow) * DM + c;
                    *(f32x4*)o = v0; *(f32x4*)(o + 4) = v1; } }
    }
};
struct EpiF32 {
    static constexpr bool PERM = false;
    float* C; int ldc;
    __device__ __forceinline__ void operator()(AccRef acc, const Unit& u, int wr, int wc, int fr, int fq) const {
        const int row0 = u.pm * BM + wr * 64 + fr, col0 = u.pn * BM + wc * 32 + 4 * fq;
#pragma unroll
        for (int ai = 0; ai < 2; ++ai)
#pragma unroll
            for (int m = 0; m < 4; ++m) { float* rowp = C + (size_t)(row0 + ai * HALF + m * 16) * ldc + col0;
#pragma unroll
                for (int bj = 0; bj < 2; ++bj)
#pragma unroll
                    for (int n = 0; n < 2; ++n) *(f32x4*)(rowp + bj * HALF + n * 16) = acc[ai][bj][m][n]; }
    }
};
struct EpiF32S {
    static constexpr bool PERM = false;
    float* C;
    __device__ __forceinline__ void operator()(AccRef acc, const Unit& u, int wr, int wc, int fr, int fq) const {
        const int row0 = (u.pm ? 256 : 0) + wr * 64 + fr, col0 = (u.pn & 7) * BM + wc * 32 + 4 * fq; float* base = C + (size_t)(u.pn >> 3) * 512 * DM;
#pragma unroll
        for (int ai = 0; ai < 2; ++ai)
#pragma unroll
            for (int m = 0; m < 4; ++m) { float* rowp = base + (size_t)(row0 + ai * HALF + m * 16) * DM + col0;
#pragma unroll
                for (int bj = 0; bj < 2; ++bj)
#pragma unroll
                    for (int n = 0; n < 2; ++n) *(f32x4*)(rowp + bj * HALF + n * 16) = acc[ai][bj][m][n]; }
    }
};
struct EpiSwiGLU {
    static constexpr bool PERM = true;
    bf16_t* O;
    __device__ __forceinline__ void operator()(AccRef acc, const Unit& u, int wr, int wc, int fr, int fq) const {
        const int row0 = u.pm * BM + wr * 64 + fr, col0 = u.pn * 128 + wc * 32 + 8 * fq;
#pragma unroll
        for (int ai = 0; ai < 2; ++ai)
#pragma unroll
            for (int m = 0; m < 4; ++m) { f32x4 v0, v1;
#pragma unroll
                for (int j = 0; j < 4; ++j) { const float g0 = acc[ai][0][m][0][j], g1 = acc[ai][0][m][1][j];
                    v0[j] = g0 * sigmoidf_(g0) * acc[ai][1][m][0][j]; v1[j] = g1 * sigmoidf_(g1) * acc[ai][1][m][1][j]; }
                u32x4 w; w.x = cvt_pk_bf16(v0[0], v0[1]); w.y = cvt_pk_bf16(v0[2], v0[3]); w.z = cvt_pk_bf16(v1[0], v1[1]); w.w = cvt_pk_bf16(v1[2], v1[3]);
                *(u32x4*)(O + (size_t)(row0 + ai * HALF + m * 16) * FF + col0) = w; }
    }
};
}

namespace att {
constexpr int SHM_V = 16384, OFF_V = 0, OFF_K = 32768, OFF_WS = 32768 + 49152, OFF_RPB = OFF_WS + 2048, RPB_PAD = 64, OFF_Q = OFF_RPB + 2560;
#define SBAR() __builtin_amdgcn_sched_barrier(0)
__device__ __forceinline__ int crow(int r, int hi) { return (r & 3) + 8 * (r >> 2) + 4 * hi; }
template <int DQK> __device__ __forceinline__ int kswz(int row, int colB) { return row * (DQK * 2) + (colB ^ ((row & 7) << 4)); }

template <int DQK> struct Scl;
template <> struct Scl<192> { static constexpr float SCALE = 0.07216878364870322f; };
template <> struct Scl<128> { static constexpr float SCALE = 0.08838834764831845f; };
constexpr float THR = 8.f;

struct NaMask { bool lat, rowok; int bidx, cs; };

template <int DQK, int MODE>
__device__ __forceinline__ void partialSM(f32x16& p0, f32x16& p1, float& m_reg, float& mn, float& alpha, const NaMask& mk, const LAS float* rpbT, int hi) {
    constexpr float SCALE = Scl<DQK>::SCALE, C = SCALE * 1.4426950408889634f;
    if (MODE == 1) { if (mk.lat) {
        int csv = mk.cs - 4 * hi; asm volatile("" : "+v"(csv));
#pragma unroll
        for (int r = 0; r < 16; ++r) { const int ko = (r & 3) + 8 * (r >> 2); const int kc = ko;
            const float b0 = rpbT[mk.bidx + ko], b1 = rpbT[mk.bidx + 32 + ko];
            const bool ok0 = mk.rowok && (unsigned)(kc - csv) < 16u, ok1 = mk.rowok && (unsigned)(kc + 32 - csv) < 16u;
            p0[r] = ok0 ? p0[r] + b0 * (1.f / SCALE) : -3.0e38f; p1[r] = ok1 ? p1[r] + b1 * (1.f / SCALE) : -3.0e38f; } } }
    float pmax = p0[0];
#pragma unroll
    for (int r = 1; r < 16; ++r) pmax = fmaxf(pmax, p0[r]);
#pragma unroll
    for (int r = 0; r < 16; ++r) pmax = fmaxf(pmax, p1[r]);
    { auto rr = __builtin_amdgcn_permlane32_swap(__float_as_uint(pmax), __float_as_uint(pmax), false, false);
      pmax = fmaxf(__uint_as_float(rr[0]), __uint_as_float(rr[1])); }
    if (__builtin_expect(__all(pmax - m_reg <= THR / SCALE), 1)) { mn = m_reg; alpha = 1.f; }
    else { mn = fmaxf(m_reg, pmax); alpha = __builtin_amdgcn_exp2f((m_reg - mn) * C); m_reg = mn; }
    const float mnC = -mn * C;
#pragma unroll
    for (int r = 0; r < 16; ++r) p0[r] = fmaf(p0[r], C, mnC);
#pragma unroll
    for (int r = 0; r < 16; ++r) p1[r] = fmaf(p1[r], C, mnC);
#pragma unroll
    for (int r = 0; r < 16; ++r) p0[r] = __builtin_amdgcn_exp2f(p0[r]);
}
__device__ __forceinline__ void finishSM(f32x16& p0, f32x16& p1, float alpha, float& l_reg, bf16x8& pa0, bf16x8& pa1, bf16x8& pa2, bf16x8& pa3) {
#pragma unroll
    for (int r = 0; r < 16; ++r) p1[r] = __builtin_amdgcn_exp2f(p1[r]);
    float ps = 0;
#pragma unroll
    for (int r = 0; r < 16; ++r) ps += p0[r];
#pragma unroll
    for (int r = 0; r < 16; ++r) ps += p1[r];
    { auto rr = __builtin_amdgcn_permlane32_swap(__float_as_uint(ps), __float_as_uint(ps), false, false);
      ps = __uint_as_float(rr[0]) + __uint_as_float(rr[1]); }
    l_reg = l_reg * alpha + ps;
#define PK4(P, BASE, OUT) do { unsigned a0 = cvt_pk_bf16(P[BASE + 0], P[BASE + 1]), a1 = cvt_pk_bf16(P[BASE + 2], P[BASE + 3]);   \
    unsigned b0 = cvt_pk_bf16(P[BASE + 4], P[BASE + 5]), b1 = cvt_pk_bf16(P[BASE + 6], P[BASE + 7]);                              \
    auto r0 = __builtin_amdgcn_permlane32_swap(a0, b0, false, false); auto r1 = __builtin_amdgcn_permlane32_swap(a1, b1, false, false); \
    u32x4 w = {r0[0], r1[0], r0[1], r1[1]}; OUT = *reinterpret_cast<bf16x8*>(&w); } while (0)
    PK4(p0, 0, pa0); PK4(p0, 8, pa1); PK4(p1, 0, pa2); PK4(p1, 8, pa3);
#undef PK4
}
template <int DQK>
__device__ __forceinline__ void qkt(f32x16& p0, f32x16& p1, const char* Ks, const bf16x8* qr, const char* qx, int r32, int hi) {
    p0 = f32x16{}; p1 = f32x16{};
#pragma unroll
    for (int d0 = 0; d0 < DQK / 16; ++d0) { const int cb = (d0 * 16 + hi * 8) * 2;
        const bf16x8 b0 = *reinterpret_cast<const bf16x8*>(Ks + kswz<DQK>(r32, cb));
        const bf16x8 b1 = *reinterpret_cast<const bf16x8*>(Ks + kswz<DQK>(32 + r32, cb));
        constexpr int NQR = 8; bf16x8 q; if (d0 < NQR) q = qr[d0]; else q = *reinterpret_cast<const bf16x8*>(qx + (d0 - NQR) * 1024);
        p0 = __builtin_amdgcn_mfma_f32_32x32x16_bf16(b0, q, p0, 0, 0, 0);
        p1 = __builtin_amdgcn_mfma_f32_32x32x16_bf16(b1, q, p1, 0, 0, 0); }
}
__device__ __forceinline__ int v_st(int k, int c) { const int kk = (k & ~0xC) | ((k & 4) << 1) | ((k & 8) >> 1); return ((kk >> 3) * 4 + (c >> 5)) * 512 + ((kk & 7) * 32 + (c & 31)) * 2; }
__device__ __forceinline__ int v_rd_base(int lane) { return ((lane & 3) << 3) | (((lane >> 2) & 3) << 6) | (((lane >> 4) & 1) << 5) | (((lane >> 5) & 1) << 8); }
constexpr int v_rd_off(int d0, int ks, int half) { return d0 * 512 + ks * 4096 + half * 2048; }
template <int OFF> __device__ __forceinline__ s16x4 tr_read(int vb) {
    s16x4 r; asm volatile("ds_read_b64_tr_b16 %0, %1 offset:%2" : "=&v"(r) : "v"(vb), "i"(OFF) : "memory"); return r;
}
template <int D0> __device__ __forceinline__ void pv_one(f32x16& od, int vb, bf16x8 pa0, bf16x8 pa1, bf16x8 pa2, bf16x8 pa3) {
    const s16x4 l0 = tr_read<v_rd_off(D0, 0, 0)>(vb), h0 = tr_read<v_rd_off(D0, 0, 1)>(vb), l1 = tr_read<v_rd_off(D0, 1, 0)>(vb), h1 = tr_read<v_rd_off(D0, 1, 1)>(vb);
    const s16x4 l2 = tr_read<v_rd_off(D0, 2, 0)>(vb), h2 = tr_read<v_rd_off(D0, 2, 1)>(vb), l3 = tr_read<v_rd_off(D0, 3, 0)>(vb), h3 = tr_read<v_rd_off(D0, 3, 1)>(vb);
    asm volatile("s_waitcnt lgkmcnt(0)" ::: "memory"); SBAR();
#define PK(L, H) (bf16x8){L[0], L[1], L[2], L[3], H[0], H[1], H[2], H[3]}
    od = __builtin_amdgcn_mfma_f32_32x32x16_bf16(pa0, PK(l0, h0), od, 0, 0, 0);
    od = __builtin_amdgcn_mfma_f32_32x32x16_bf16(pa1, PK(l1, h1), od, 0, 0, 0);
    od = __builtin_amdgcn_mfma_f32_32x32x16_bf16(pa2, PK(l2, h2), od, 0, 0, 0);
    od = __builtin_amdgcn_mfma_f32_32x32x16_bf16(pa3, PK(l3, h3), od, 0, 0, 0);
#undef PK
}
__device__ __forceinline__ void pv_d0(f32x16* o, int vb, bf16x8 pa0, bf16x8 pa1, bf16x8 pa2, bf16x8 pa3) {
    pv_one<0>(o[0], vb, pa0, pa1, pa2, pa3); pv_one<1>(o[1], vb, pa0, pa1, pa2, pa3); pv_one<2>(o[2], vb, pa0, pa1, pa2, pa3); pv_one<3>(o[3], vb, pa0, pa1, pa2, pa3);
}

template <int DQK, int MODE, int SDEPTH, bool EARLY = false>
__device__ __forceinline__ void attn_unit(const bf16_t* __restrict__ Qb, int ldq, const bf16_t* __restrict__ Kg, int ldk, const bf16_t* __restrict__ Vg, int ldv,
                                          bf16_t* __restrict__ Ob, int ldo, int NT, int base0, int n0, int base1, int R0, int lo, const float* __restrict__ rpb_h, char* lds) {
    const int tid = tid_opaque(), wid = tid >> 6, lane = tid & 63, r32 = lane & 31, hi = lane >> 5;
    constexpr int SHM_K = 64 * DQK * 2;
    char* V_lds = lds + OFF_V; char* K_lds = lds + OFF_K;
    float* ws = (float*)(lds + OFF_WS) + wid * 64; float* li_l = ws; float* al_l = ws + 32;
    const LAS float* rpbT = (const LAS float*)(LAS char*)(lds + OFF_RPB);
    __syncthreads();
    if (MODE == 1) { if (tid < 465) ((float*)(lds + OFF_RPB))[RPB_PAD + tid] = rpb_h[tid]; }
    float m_reg = -1e30f, l_reg = 0; f32x16 o[4] = {}; bf16x8 qr[8];
    const bf16_t* Qw = Qb + (long)(wid * 32 + r32) * ldq + hi * 8;
    constexpr int NQR = 8;
    char* qx = lds + OFF_Q + wid * 7168 + lane * 16;
#pragma unroll
    for (int d0 = 0; d0 < NQR; ++d0) qr[d0] = *reinterpret_cast<const bf16x8*>(Qw + d0 * 16);
    if (DQK == 192) {
#pragma unroll
        for (int d0 = NQR; d0 < 12; ++d0) *reinterpret_cast<bf16x8*>(qx + (d0 - NQR) * 1024) = *reinterpret_cast<const bf16x8*>(Qw + d0 * 16);
    }
    const int sr = tid >> 4, sc = (tid & 15) * 8, vst0 = v_st(sr, sc), vst1 = v_st(32 + sr, sc);
    const int sr2 = tid >> 3, sc2 = 128 + (tid & 7) * 8;
    const int vb0 = (int)(uintptr_t)(LAS char*)V_lds + v_rd_base(lane);
    const int qrow = R0 + (wid >> 1), qc = (wid & 1) * 32 + r32;
    const int rs_ = min(max(qrow - 4, 0), 56), cs_ = min(max(qc - 8, 0), 48);
    auto mk_of = [&](int j) { NaMask mk; mk.lat = (MODE == 1) && (j >= 4); const int kr = lo + j - 4; mk.rowok = (kr >= rs_) && (kr < rs_ + 8);
        const int dr = min(max(kr - qrow + 7, 0), 14); mk.bidx = RPB_PAD + dr * 31 + 15 - qc + 4 * hi; mk.cs = cs_; return mk; };
    auto krow = [&](int j) -> long { return (j < n0) ? (long)base0 + 64 * j : (long)base1 + 64 * (j - n0); };
    struct { bf16x8 vs0, vs1, ks0, ks1, ks2; } sr_[SDEPTH];
#define SLOAD(i, tj) do { const long kr__ = krow(tj); \
    sr_[i].vs0 = *reinterpret_cast<const bf16x8*>(Vg + (kr__ + sr) * ldv + sc); sr_[i].vs1 = *reinterpret_cast<const bf16x8*>(Vg + (kr__ + 32 + sr) * ldv + sc); \
    sr_[i].ks0 = *reinterpret_cast<const bf16x8*>(Kg + (kr__ + sr) * ldk + sc); sr_[i].ks1 = *reinterpret_cast<const bf16x8*>(Kg + (kr__ + 32 + sr) * ldk + sc); \
    if (DQK == 192) sr_[i].ks2 = *reinterpret_cast<const bf16x8*>(Kg + (kr__ + sr2) * ldk + sc2); } while (0)
#define SWRITE(b, i) do { *(bf16x8*)(V_lds + (b) * SHM_V + vst0) = sr_[i].vs0; *(bf16x8*)(V_lds + (b) * SHM_V + vst1) = sr_[i].vs1; \
    *(bf16x8*)(K_lds + (b) * SHM_K + kswz<DQK>(sr, sc * 2)) = sr_[i].ks0; *(bf16x8*)(K_lds + (b) * SHM_K + kswz<DQK>(32 + sr, sc * 2)) = sr_[i].ks1; \
    if (DQK == 192) *(bf16x8*)(K_lds + (b) * SHM_K + kswz<DQK>(sr2, sc2 * 2)) = sr_[i].ks2; } while (0)
#define SWAIT() do { if constexpr (SDEPTH == 2) { if constexpr (DQK == 192) asm volatile("s_waitcnt vmcnt(5)" ::: "memory"); else asm volatile("s_waitcnt vmcnt(4)" ::: "memory"); } \
    else asm volatile("s_waitcnt vmcnt(0)" ::: "memory"); } while (0)
#define RESC(a) do { if (__any((a) < 1.f)) { if (hi == 0) al_l[r32] = (a); asm volatile("s_waitcnt lgkmcnt(0)" ::: "memory"); \
    _Pragma("unroll") for (int d = 0; d < 4; ++d) _Pragma("unroll") for (int r = 0; r < 16; ++r) o[d][r] *= al_l[crow(r, hi)]; } } while (0)
    f32x16 pA0, pA1, pB0, pB1; float mnA, mnB, alA, alB; bf16x8 pa0, pa1, pa2, pa3;
    constexpr int SE = 0, SO = SDEPTH - 1;
    SLOAD(SE, 0); asm volatile("s_waitcnt vmcnt(0)" ::: "memory"); SWRITE(0, SE); __syncthreads();
    qkt<DQK>(pA0, pA1, K_lds, qr, qx, r32, hi); partialSM<DQK, MODE>(pA0, pA1, m_reg, mnA, alA, mk_of(0), rpbT, hi);
    SLOAD(SO, 1); if constexpr (SDEPTH == 2) { if (2 < NT) SLOAD(SE, 2); }
    SWAIT(); SWRITE(1, SO); if constexpr (EARLY) { if (2 < NT) SLOAD(SE, 2); } __syncthreads();
#pragma unroll 1
    for (int j = 1; j + 1 < NT; j += 2) {
        SBAR(); qkt<DQK>(pB0, pB1, K_lds + SHM_K, qr, qx, r32, hi);
        finishSM(pA0, pA1, alA, l_reg, pa0, pa1, pa2, pa3); SBAR();
        if constexpr (SDEPTH == 2) { SLOAD(SO, j + 2); } else if constexpr (!EARLY) { SLOAD(SE, j + 1); } SBAR();
        pv_d0(o, vb0, pa0, pa1, pa2, pa3); partialSM<DQK, MODE>(pB0, pB1, m_reg, mnB, alB, mk_of(j), rpbT, hi);
        __syncthreads(); SWAIT(); SWRITE(0, SE);
        if constexpr (EARLY) { SLOAD(SO, j + 2); }
        RESC(alB); __syncthreads();
        SBAR(); qkt<DQK>(pA0, pA1, K_lds, qr, qx, r32, hi);
        finishSM(pB0, pB1, alB, l_reg, pa0, pa1, pa2, pa3); SBAR();
        if constexpr (SDEPTH == 2) { if (j + 3 < NT) SLOAD(SE, j + 3); } else if constexpr (!EARLY) { SLOAD(SO, j + 2); } SBAR();
        pv_d0(o, vb0 + SHM_V, pa0, pa1, pa2, pa3); partialSM<DQK, MODE>(pA0, pA1, m_reg, mnA, alA, mk_of(j + 1), rpbT, hi);
        __syncthreads(); SWAIT(); SWRITE(1, SO);
        if constexpr (EARLY) { if (j + 3 < NT) SLOAD(SE, j + 3); }
        RESC(alA); __syncthreads();
    }
    SBAR(); qkt<DQK>(pB0, pB1, K_lds + SHM_K, qr, qx, r32, hi);
    finishSM(pA0, pA1, alA, l_reg, pa0, pa1, pa2, pa3); SBAR();
    pv_d0(o, vb0, pa0, pa1, pa2, pa3); partialSM<DQK, MODE>(pB0, pB1, m_reg, mnB, alB, mk_of(NT - 1), rpbT, hi);
    __syncthreads(); RESC(alB);
    finishSM(pB0, pB1, alB, l_reg, pa0, pa1, pa2, pa3); SBAR();
    pv_d0(o, vb0 + SHM_V, pa0, pa1, pa2, pa3);
    if (hi == 0) li_l[r32] = l_reg; asm volatile("s_waitcnt lgkmcnt(0)" ::: "memory");
    float rli[16];
#pragma unroll
    for (int r = 0; r < 16; ++r) rli[r] = __builtin_amdgcn_rcpf(li_l[crow(r, hi)]);
    bf16_t* Ow = Ob + (long)(wid * 32) * ldo;
#pragma unroll
    for (int r = 0; r < 16; ++r) { const int orow = crow(r, hi);
#pragma unroll
        for (int d0 = 0; d0 < 4; ++d0) Ow[(long)orow * ldo + d0 * 32 + r32] = (bf16_t)f2bf(o[d0][r] * rli[r]); }
#undef SLOAD
#undef SWRITE
#undef SWAIT
#undef RESC
}
}

template <class RM>
__device__ __forceinline__ void tr_item(const float* __restrict__ W, int ldw, int k0, int n0, const float* __restrict__ gk, bf16_t* __restrict__ WT, int ldt, int kdst0, RM rm, float* scr, int lane) {
    float v[32];
#pragma unroll
    for (int i = 0; i < 32; ++i) v[i] = W[(size_t)(k0 + 2 * i + (lane >> 5)) * ldw + n0 + (lane & 31)];
    if (gk) {
#pragma unroll
        for (int i = 0; i < 32; ++i) v[i] *= gk[k0 + 2 * i + (lane >> 5)]; }
#pragma unroll
    for (int i = 0; i < 32; ++i) scr[(2 * i + (lane >> 5)) * 33 + (lane & 31)] = v[i];
    LDS_WAIT(); asm volatile("" ::: "memory");
    const int c = lane & 7;
#pragma unroll
    for (int j = 0; j < 4; ++j) { const int n = (lane >> 3) + 8 * j; const float* s = scr + (8 * c) * 33 + n;
        u32x4 o; o.x = pk2(s[0 * 33], s[1 * 33]); o.y = pk2(s[2 * 33], s[3 * 33]); o.z = pk2(s[4 * 33], s[5 * 33]); o.w = pk2(s[6 * 33], s[7 * 33]);
        *(u32x4*)(WT + (size_t)rm(n0 + n) * ldt + kdst0 + k0 + 8 * c) = o; }
    LDS_WAIT(); asm volatile("" ::: "memory");
}
struct RmId { int off; __device__ int operator()(int n) const { return n + off; } };
struct RmQ { __device__ int operator()(int n) const { const int head = n / 192, d = n % 192; if (d < 128) return n; const int p = d - 128, axis = p >> 5, w = p & 31, par = w >> 4, f = w & 15; return head * 192 + 128 + axis * 32 + 2 * f + par; } };
struct RmGU { int up; __device__ int operator()(int n) const { return (n >> 7) * 256 + up * 128 + (n & 127); } };

constexpr int I_IN = 32 * 378, I_Q = 8 * 48, I_KV = 4 * 64, I_G = 256, I_M = 16 * 64, I_OUT = 32 * 64, I_GU = 32 * 176, I_DN = 88 * 64;
constexpr int I_LAYER = I_IN + I_Q + I_KV + I_G + 3 * I_M + I_OUT + 2 * I_GU + I_DN;
constexpr int R_M0 = I_IN + I_Q + I_KV + I_G, N_DEF1 = 3 * I_M + I_OUT;
constexpr int DJ_DN = N_DEF1, DJ_GU = DJ_DN + I_DN, DJ_IN = DJ_GU + 2 * I_GU, DJ_END = DJ_IN + I_IN;
__device__ __forceinline__ void convert_item(const Params& p, int l, int r, float* scr, int lane) {
    unsigned char* wl = p.ws + WS_W + (size_t)l * W_LAYER;
    if (r < I_IN) { tr_item(p.in[10] + (size_t)l * DM * INW, INW, (r / 378) * 64, (r % 378) * 32, nullptr, (bf16_t*)(wl + W_IN), DM, 0, RmId{0}, scr, lane); return; } r -= I_IN;
    if (r < I_Q) { tr_item(p.in[12] + (size_t)l * 512 * 1536, 1536, (r / 48) * 64, (r % 48) * 32, p.in[11] + l * 512, (bf16_t*)(wl + W_Q), 512, 0, RmQ{}, scr, lane); return; } r -= I_Q;
    if (r < I_KV) { tr_item(p.in[14] + (size_t)l * 256 * 2048, 2048, (r / 64) * 64, (r % 64) * 32, p.in[13] + l * 256, (bf16_t*)(wl + W_KV), 256, 0, RmId{0}, scr, lane); return; } r -= I_KV;
    if (r < I_G) { const int sub = r & 7, blk = r >> 3, h = blk & 7, dir = (blk >> 3) & 1, gate = blk >> 4;
        const float* W = (gate ? p.in[20] : p.in[18]) + ((size_t)(l * 2 + dir) * 8 + h) * 128 * 128;
        tr_item(W, 128, (sub >> 2) * 64, (sub & 3) * 32, nullptr, (bf16_t*)(wl + W_G), 256, (h & 1) * 128, RmId{(dir * 8 + h) * 256 + gate * 128}, scr, lane); return; } r -= I_G;
    if (r < 3 * I_M) { const int k = r / I_M, rr = r % I_M; const float* W = (k == 0 ? p.in[15] : k == 1 ? p.in[23] : p.in[25]) + (size_t)l * 1024 * DM;
        tr_item(W, DM, (rr / 64) * 64, (rr % 64) * 32, nullptr, (bf16_t*)(wl + W_MRG) + (size_t)k * DM * 1024, 1024, 0, RmId{0}, scr, lane); return; } r -= 3 * I_M;
    if (r < I_OUT) { tr_item(p.in[26] + (size_t)l * DM * DM, DM, (r / 64) * 64, (r % 64) * 32, nullptr, (bf16_t*)(wl + W_OUT), DM, 0, RmId{0}, scr, lane); return; } r -= I_OUT;
    if (r < 2 * I_GU) { const int up = r / I_GU, rr = r % I_GU; const float* W = (up ? p.in[28] : p.in[27]) + (size_t)l * DM * FF;
        tr_item(W, FF, (rr / 176) * 64, (rr % 176) * 32, nullptr, (bf16_t*)(wl + W_GU), DM, 0, RmGU{up}, scr, lane); return; } r -= 2 * I_GU;
    tr_item(p.in[29] + (size_t)l * FF * DM, DM, (r / 64) * 64, (r % 64) * 32, nullptr, (bf16_t*)(wl + W_DN), FF, 0, RmId{0}, scr, lane);
}
__device__ __forceinline__ void convert_deferred(const Params& p, char* lds, int first, int j0, int j1) {
    const int G = gridDim.x; if (G != 256) first = 0;
    if ((int)blockIdx.x < first) return;
    const int tid = tid_opaque(), lane = tid & 63, wave = tid >> 6; float* scr = (float*)(lds + wave * 8448);
    const int gw = ((int)blockIdx.x - first) * NWAVES + wave, NGW = (G - first) * NWAVES;
    for (int j = j0 + gw; j < j1; j += NGW) {
        const int r = j < DJ_DN ? R_M0 + j : j < DJ_GU ? (I_LAYER - I_DN) + (j - DJ_DN) : j < DJ_IN ? R_M0 + N_DEF1 + (j - DJ_GU) : j - DJ_IN;
        convert_item(p, 1, r, scr, lane); }
    __syncthreads();
}
__device__ __forceinline__ void phase0(const Params& p, char* lds) {
    const int tid = tid_opaque(), lane = tid & 63, wave = tid >> 6;
    unsigned char* ws = p.ws;
    {
        float* s = (float*)lds; float* red = (float*)(lds + 24576);
        for (int i = tid; i < 3 * DM; i += NTHR) { const int v = i / DM, k = i % DM; const float x = (v < 2) ? p.in[1][v * DM + k] : p.in[3][k]; s[i] = x / (1.f + __expf(-x)); }
        __syncthreads();
        float* mods = (float*)(ws + WS_MODS);
        for (int grp = blockIdx.x; grp < 256; grp += gridDim.x) {
            const int l = grp >> 7, n0 = (grp & 127) * 96; const float* W = p.in[4] + (size_t)l * DM * 12288;
            const int kg = tid >> 5, cl = tid & 31; const bool act = cl < 24;
            f32x4 a0 = {0, 0, 0, 0}, a1 = a0, a2 = a0;
            if (act) {
#pragma unroll 8
                for (int i = 0; i < 128; ++i) { const int k = kg + 16 * i; const f32x4 w = *(const f32x4*)(W + (size_t)k * 12288 + n0 + 4 * cl);
                    a0 += w * s[k]; a1 += w * s[DM + k]; a2 += w * s[2 * DM + k]; }
                *(f32x4*)(red + (kg * 3 + 0) * 128 + 4 * cl) = a0; *(f32x4*)(red + (kg * 3 + 1) * 128 + 4 * cl) = a1; *(f32x4*)(red + (kg * 3 + 2) * 128 + 4 * cl) = a2; }
            __syncthreads();
            if (tid < 384) { const int v = tid >> 7, n = tid & 127; if (n < 96) { float acc = p.in[5][l * 12288 + n0 + n];
                for (int g2 = 0; g2 < 16; ++g2) acc += red[(g2 * 3 + v) * 128 + n];
                mods[(size_t)(l * 3 + v) * 12288 + n0 + n] = acc; } }
            __syncthreads();
        }
    }
    {
        float* cosT = (float*)(ws + WS_ROPE); float* sinT = cosT + SEQ * 32;
        for (int i = blockIdx.x * NTHR + tid; i < SEQ * 32; i += gridDim.x * NTHR) { const int t = i >> 5, j = i & 31, axis = j >> 4, f = j & 15;
            const float pos = (float)(axis ? (t & 63) : (t >> 6)); const float inv = powf(10000.0f, -(float)f / 16.0f); const float ang = pos * inv;
            cosT[i] = cosf(ang); sinT[i] = sinf(ang); }
    }
    { float* spt = (float*)(ws + WS_SPT); for (int i = blockIdx.x * NTHR + tid; i < 4096; i += gridDim.x * NTHR) spt[i] = -8.f * log1pf(expf(-p.in[22][i])); }
    float* scr = (float*)(lds + wave * 8448);
    const int gw = blockIdx.x * NWAVES + wave, NGW = gridDim.x * NWAVES;
    for (int it = gw; it < I_LAYER + (R_M0 - I_IN); it += NGW) {
        if (it < I_LAYER) convert_item(p, 0, it, scr, lane); else convert_item(p, 1, I_IN + (it - I_LAYER), scr, lane);
    }
    for (int i = blockIdx.x * NTHR + tid; i < 2 * 4096 * 16; i += gridDim.x * NTHR) { const int l = i >> 16, row = (i >> 4) & 4095, ch = i & 15; const int h = (row >> 8) & 7;
        bf16_t* dst = (bf16_t*)(ws + WS_W + (size_t)l * W_LAYER + W_G) + (size_t)row * 256 + ((h & 1) ^ 1) * 128 + ch * 8;
        *(u32x4*)dst = (u32x4){0u, 0u, 0u, 0u}; }
}

__device__ __forceinline__ float* xrow_ptr(const Params& p, int row) {
    const int b = row / RPB, rr = row % RPB;
    return rr < CTX ? (float*)(p.ws + WS_XC) + (size_t)(b * CTX + rr) * DM : p.out + (size_t)(b * SEQ + rr - CTX) * DM;
}
__device__ __forceinline__ void row_pass(const Params& p, int mode, const float* Z, const float* ZS, const float* gpost, const float* mods_res, int kg,
                                         const float* gpre, const float* mods_mod, int ksh, int ksc, bf16_t* H, bool skip_ctx) {
    const int tid = tid_opaque(), lane = tid & 63, wave = tid >> 6;
    const int gw = blockIdx.x * NWAVES + wave, NGW = gridDim.x * NWAVES;
    for (int row = gw; row < MROWS; row += NGW) {
        const int b = row / RPB, rr = row % RPB; const bool isctx = rr < CTX; const int v = isctx ? 2 : b;
        if (skip_ctx && isctx) continue;
        bf16_t* xr = (bf16_t*)(p.ws + WS_XB) + (size_t)row * DM;
        f32x4 x[8];
        if (mode == 0) { const float* src = isctx ? p.in[2] + (size_t)(b * CTX + rr) * DM : p.in[0] + (size_t)(b * SEQ + rr - CTX) * DM;
#pragma unroll
            for (int j = 0; j < 8; ++j) x[j] = *(const f32x4*)(src + 4 * lane + 256 * j);
        } else {
            f32x4 z[8]; float ss = 0.f;
            const float* xs = isctx ? p.in[2] + (size_t)(b * CTX + rr) * DM : p.in[0] + (size_t)(b * SEQ + rr - CTX) * DM;
#pragma unroll
            for (int j = 0; j < 8; ++j) { if (mode == 2) x[j] = *(const f32x4*)(xs + 4 * lane + 256 * j);
                else { const u32x2 xw = *(const u32x2*)(xr + 4 * lane + 256 * j); x[j] = (f32x4){bflo(xw.x), bfhi(xw.x), bflo(xw.y), bfhi(xw.y)}; }
                if (ZS && isctx) { const float* zp = ZS + (size_t)(b * CTX + rr) * DM + 4 * lane + 256 * j;
                    z[j] = (*(const f32x4*)zp + *(const f32x4*)(zp + (size_t)512 * DM)) + (*(const f32x4*)(zp + (size_t)1024 * DM) + *(const f32x4*)(zp + (size_t)1536 * DM)); }
                else { const u32x2 zw = *(const u32x2*)((const bf16_t*)Z + (size_t)row * DM + 4 * lane + 256 * j); z[j] = (f32x4){bflo(zw.x), bfhi(zw.x), bflo(zw.y), bfhi(zw.y)}; }
                ss += (z[j][0] * z[j][0] + z[j][1] * z[j][1]) + (z[j][2] * z[j][2] + z[j][3] * z[j][3]); }
            const float rs = rsqrtf(wave_sum(ss) * (1.f / DM) + EPS);
            const float* gt = mods_res + (size_t)v * 12288 + kg * DM;
#pragma unroll
            for (int j = 0; j < 8; ++j) { const f32x4 g = *(const f32x4*)(gt + 4 * lane + 256 * j), gp = *(const f32x4*)(gpost + 4 * lane + 256 * j);
                x[j] += g * (z[j] * rs * gp); }
        }
        if (mode == 3) { float* orow = p.out + (size_t)(b * SEQ + rr - CTX) * DM;
#pragma unroll
            for (int j = 0; j < 8; ++j) *(f32x4*)(orow + 4 * lane + 256 * j) = x[j]; }
        else if (mode != 0) {
#pragma unroll
            for (int j = 0; j < 8; ++j) { u32x2 w; w.x = cvt_pk_bf16(x[j][0], x[j][1]); w.y = cvt_pk_bf16(x[j][2], x[j][3]); *(u32x2*)(xr + 4 * lane + 256 * j) = w; } }
        if (gpre) {
            float ss = 0.f;
#pragma unroll
            for (int j = 0; j < 8; ++j) ss += (x[j][0] * x[j][0] + x[j][1] * x[j][1]) + (x[j][2] * x[j][2] + x[j][3] * x[j][3]);
            const float rs = rsqrtf(wave_sum(ss) * (1.f / DM) + EPS);
            const float* sh = mods_mod + (size_t)v * 12288 + ksh * DM; const float* sc = mods_mod + (size_t)v * 12288 + ksc * DM;
#pragma unroll
            for (int j = 0; j < 8; ++j) { const int c = 4 * lane + 256 * j; const f32x4 g = *(const f32x4*)(gpre + c), s1 = *(const f32x4*)(sc + c), s0 = *(const f32x4*)(sh + c);
                const f32x4 hv = x[j] * rs * g * (s1 + 1.f) + s0;
                u32x2 w; w.x = cvt_pk_bf16(hv[0], hv[1]); w.y = cvt_pk_bf16(hv[2], hv[3]);
                *(u32x2*)(H + (size_t)row * DM + c) = w; }
        }
    }
}

__device__ __forceinline__ void phase_p2(const Params& p, int l) {
    unsigned char* ws = p.ws; const bf16_t* P = (const bf16_t*)(ws + WS_R1);
    const int tid = tid_opaque(), lane = tid & 63, wave = tid >> 6;
    { bf16_t* UC = (bf16_t*)(ws + WS_R2 + R2_UC); const float* cw = p.in[16] + (size_t)l * 4 * 1024; const float* cb = p.in[17] + (size_t)l * 1024;
      for (int t = blockIdx.x * NTHR + tid; t < 512 * 256; t += gridDim.x * NTHR) { const int c4 = (t & 255) * 4, base = (t >> 8) * 17;
          const f32x4 w0 = *(const f32x4*)(cw + c4), w1 = *(const f32x4*)(cw + 1024 + c4), w2 = *(const f32x4*)(cw + 2048 + c4), w3 = *(const f32x4*)(cw + 3072 + c4), bs = *(const f32x4*)(cb + c4);
          const bf16_t* pu = P + C_U + c4;
#define LDU(r) ({ const int r_ = min(max((r), 0), MROWS - 1); const u32x2 q_ = *(const u32x2*)(pu + (size_t)r_ * INP); (f32x4){bflo(q_.x), bfhi(q_.x), bflo(q_.y), bfhi(q_.y)}; })
          f32x4 u0 = LDU(base - 2), u1 = LDU(base - 1), u2 = LDU(base), u3 = LDU(base + 1);
#pragma unroll
          for (int i = 0; i < 17; ++i) { const int row = base + i, rr = row % RPB; const int lo = rr < CTX ? 0 : CTX, hi = rr < CTX ? CTX : RPB;
              f32x4 un = u3; if (i < 16) un = LDU(row + 2);
              f32x4 acc = bs;
              if (rr - 2 >= lo) acc += w0 * u0;
              if (rr - 1 >= lo) acc += w1 * u1;
              acc += w2 * u2;
              if (rr + 1 < hi) acc += w3 * u3;
              u32x2 o; o.x = pk2(acc[0], acc[1]); o.y = pk2(acc[2], acc[3]);
              *(u32x2*)(UC + (size_t)row * 1024 + c4) = o;
              u0 = u1; u1 = u2; u2 = u3; u3 = un; }
#undef LDU
      } }
    { float* rsq = (float*)(ws + WS_RS); float* rskv = rsq + MROWS; bf16_t* KF = (bf16_t*)(ws + WS_R2 + R2_KF);
      const float* cosT = (const float*)(ws + WS_ROPE); const float* sinT = cosT + SEQ * 32;
      const int gw = blockIdx.x * NWAVES + wave, NGW = gridDim.x * NWAVES;
      for (int row = gw; row < MROWS; row += NGW) { const bf16_t* pr = P + (size_t)row * INP;
          const u32x4 qw = *(const u32x4*)(pr + 8 * lane);
          float s = bflo(qw.x) * bflo(qw.x) + bfhi(qw.x) * bfhi(qw.x) + bflo(qw.y) * bflo(qw.y) + bfhi(qw.y) * bfhi(qw.y) + bflo(qw.z) * bflo(qw.z) + bfhi(qw.z) * bfhi(qw.z) + bflo(qw.w) * bflo(qw.w) + bfhi(qw.w) * bfhi(qw.w);
          s = wave_sum(s);
          float s2 = 0.f;
          if (lane < 32) { const u32x4 kw = *(const u32x4*)(pr + C_KVA + 8 * lane);
              s2 = bflo(kw.x) * bflo(kw.x) + bfhi(kw.x) * bfhi(kw.x) + bflo(kw.y) * bflo(kw.y) + bfhi(kw.y) * bfhi(kw.y) + bflo(kw.z) * bflo(kw.z) + bfhi(kw.z) * bfhi(kw.z) + bflo(kw.w) * bflo(kw.w) + bfhi(kw.w) * bfhi(kw.w); }
          s2 = wave_sum(s2);
          if (lane == 0) { rsq[row] = rsqrtf(s * (1.f / 512.f) + EPS); rskv[row] = rsqrtf(s2 * (1.f / 256.f) + EPS); }
          if (lane < 32) { const int axis = lane >> 4, f = lane & 15; const int rr = row % RPB;
              float x1 = bf2f(pr[C_KR + axis * 32 + f]), x2 = bf2f(pr[C_KR + axis * 32 + 16 + f]);
              if (rr >= CTX) { const int t = rr - CTX; const float cs = cosT[t * 32 + axis * 16 + f], sn = sinT[t * 32 + axis * 16 + f];
                  const float y1 = x1 * cs - x2 * sn, y2 = x2 * cs + x1 * sn; x1 = y1; x2 = y2; }
              const unsigned w = pk2(x1, x2);
#pragma unroll
              for (int h = 0; h < 8; ++h) *(unsigned*)(KF + (size_t)row * 1536 + h * 192 + 128 + axis * 32 + 2 * f) = w; } } }
}

constexpr int NCH = 136;
__device__ __forceinline__ size_t gcol(int d, int ch) { return (size_t)((d * 8 + (ch >> 7)) * 256 + (ch & 127)); }
__device__ __forceinline__ void scan_s1(const Params& p) {
    unsigned char* ws = p.ws; const float* Gm = (const float*)(ws + WS_R3); f32x2* AGA = (f32x2*)(ws + WS_AGG); f32x2* AGB = AGA + (size_t)4 * NCH * 512;
    const int tid = tid_opaque();
    for (int it = blockIdx.x; it < 4 * NCH; it += gridDim.x) { const int d = it & 1, c = (it >> 1) % NCH, b = it / (2 * NCH);
        const float* gp = Gm + (size_t)(b * RPB + 32 * c) * 4096 + gcol(d, 2 * tid);
        f32x2 A = {1.f, 1.f}, B = {0.f, 0.f};
#pragma unroll 8
        for (int s = 0; s < 32; ++s) { const int t = d ? 31 - s : s; const f32x2 a = *(const f32x2*)(gp + (size_t)t * 4096), bb = *(const f32x2*)(gp + (size_t)t * 4096 + 128); B = a * B + bb; A *= a; }
        const size_t o = ((size_t)(d * 2 + b) * NCH + c) * 512 + tid; AGA[o] = A; AGB[o] = B; }
}
__device__ __forceinline__ void scan_s2(const Params& p, char* lds) {
    unsigned char* ws = p.ws; const f32x2* AGA = (const f32x2*)(ws + WS_AGG); const f32x2* AGB = AGA + (size_t)4 * NCH * 512; f32x2* CAR = (f32x2*)(ws + WS_AGG) + (size_t)8 * NCH * 512;
    const int tid = tid_opaque(), w = tid >> 6, lane = tid & 63; f32x2* sa = (f32x2*)lds; f32x2* sb = sa + 512;
    for (int it = blockIdx.x; it < 32; it += gridDim.x) { const int db = it >> 3, d = db >> 1, cp = (it & 7) * 64 + lane;
        const size_t base = (size_t)db * NCH * 512 + cp;
        f32x2 A = {1.f, 1.f}, B = {0.f, 0.f};
#pragma unroll
        for (int i = 0; i < 17; ++i) { const int k = 17 * w + i, c = d == 0 ? k : (k < 8 ? 7 - k : NCH + 7 - k); const f32x2 a = AGA[base + (size_t)c * 512], bb = AGB[base + (size_t)c * 512]; B = a * B + bb; A *= a; }
        __syncthreads();
        sa[tid] = A; sb[tid] = B;
        __syncthreads();
        f32x2 h = {0.f, 0.f};
        for (int w2 = 0; w2 < w; ++w2) h = sa[w2 * 64 + lane] * h + sb[w2 * 64 + lane];
#pragma unroll
        for (int i = 0; i < 17; ++i) { const int k = 17 * w + i, c = d == 0 ? k : (k < 8 ? 7 - k : NCH + 7 - k); const f32x2 a = AGA[base + (size_t)c * 512], bb = AGB[base + (size_t)c * 512]; CAR[base + (size_t)c * 512] = h; h = a * h + bb; } }
}
__device__ __forceinline__ float gelu_tanh(float x) { const float u = 0.7978845608028654f * (x + 0.044715f * x * x * x); const float e = __expf(2.f * u); return x * (1.f - 1.f / (e + 1.f)); }
__device__ __forceinline__ void scan_s3_item(const Params& p, int it) {
    unsigned char* ws = p.ws; const float* Gm = (const float*)(ws + WS_R3); const f32x2* CAR = (const f32x2*)(ws + WS_AGG) + (size_t)8 * NCH * 512;
    const bf16_t* P = (const bf16_t*)(ws + WS_R1); bf16_t* RO = (bf16_t*)(ws + WS_MRN + 17 * MiB);
    const int tid = tid_opaque(); const int c = it % NCH, b = it / NCH, row0 = b * RPB + 32 * c;
    const float* gf = Gm + (size_t)row0 * 4096 + gcol(0, 2 * tid); const float* gb = Gm + (size_t)row0 * 4096 + gcol(1, 2 * tid);
    f32x2 hf[32]; f32x2 h = CAR[((size_t)(0 * 2 + b) * NCH + c) * 512 + tid];
#pragma unroll
    for (int t = 0; t < 32; ++t) { const f32x2 a = *(const f32x2*)(gf + (size_t)t * 4096), bb = *(const f32x2*)(gf + (size_t)t * 4096 + 128); h = a * h + bb; hf[t] = h; }
    h = CAR[((size_t)(1 * 2 + b) * NCH + c) * 512 + tid];
#pragma unroll
    for (int s = 0; s < 32; ++s) { const int t = 31 - s; const f32x2 a = *(const f32x2*)(gb + (size_t)t * 4096), bb = *(const f32x2*)(gb + (size_t)t * 4096 + 128); h = a * h + bb;
        const unsigned gw = *(const unsigned*)(P + (size_t)(row0 + t) * INP + C_RGG + 2 * tid);
        const f32x2 rec = hf[t] + h;
        *(unsigned*)(RO + (size_t)(row0 + t) * 1024 + 2 * tid) = pk2(gelu_tanh(bflo(gw)) * rec.x, gelu_tanh(bfhi(gw)) * rec.y); }
}

#define XB_TMO      128
#define XB_XCNT(j)  (256  + 64 * (j))
#define XB_XSUB(j)  (1280 + 64 * (j))
#define XB_XGEN(j)  (2304 + 64 * (j))
#define XB_TOP      3328
#define XB_TOPGEN   3392
#define XCD_BAR_WORDS 3456
#define XB_SPIN_CAP (1u << 18)
__device__ __forceinline__ unsigned xb_ld(unsigned* p)              { return __hip_atomic_load(p, __ATOMIC_RELAXED, __HIP_MEMORY_SCOPE_AGENT); }
__device__ __forceinline__ unsigned xb_add(unsigned* p, unsigned v) { return __hip_atomic_fetch_add(p, v, __ATOMIC_RELAXED, __HIP_MEMORY_SCOPE_AGENT); }
__device__ __forceinline__ unsigned xb_xcc_id() { return (unsigned)__builtin_amdgcn_s_getreg((3 << 11) | 20) & 0xFu; }
#define XB_SPIN(cond, bar) do { unsigned _sp = 0; while (cond) { __builtin_amdgcn_s_sleep(1); \
    if ((++_sp & 255u) == 0u) { if (xb_ld(&(bar)[XB_TMO])) break; if (_sp > XB_SPIN_CAP) { atomicAdd(&(bar)[XB_TMO], 1u); break; } } } } while (0)
struct XcdBarrier { unsigned* bar; unsigned x; volatile LAS unsigned* st; };
__device__ __forceinline__ XcdBarrier xcd_barrier_post(unsigned* bar, volatile LAS unsigned* st) {
    XcdBarrier b; b.bar = bar; b.x = xb_xcc_id(); b.st = st;
    if (threadIdx.x == 0) (void)xb_add(&bar[XB_XCNT(b.x)], 1u);
    return b;
}
__device__ __forceinline__ void xcd_barrier_complete(unsigned* bar, unsigned x, unsigned& nloc, unsigned& nx) {
    const unsigned G = gridDim.x * gridDim.y * gridDim.z;
    unsigned sum, cnt, mine, sp = 0u;
    for (;;) {
        sum = 0u; cnt = 0u; mine = 0u;
#pragma unroll
        for (unsigned j = 0; j < 16; ++j) { const unsigned c = xb_ld(&bar[XB_XCNT(j)]); sum += c; cnt += (c > 0u) ? 1u : 0u; mine = (j == x) ? c : mine; }
        if (sum == G) break;
        __builtin_amdgcn_s_sleep(1);
        if ((++sp & 255u) == 0u) { if (xb_ld(&bar[XB_TMO])) break; if (sp > XB_SPIN_CAP) { atomicAdd(&bar[XB_TMO], 1u); break; } }
    }
    nloc = mine > 0u ? mine : 1u; nx = cnt > 0u ? cnt : 1u;
}
__device__ __forceinline__ void xcd_barrier(const XcdBarrier& b) {
    asm volatile("s_waitcnt vmcnt(0)" ::: "memory");
    __syncthreads();
    if (threadIdx.x == 0) {
        unsigned* bar = b.bar;
        __builtin_amdgcn_s_waitcnt(0);
        unsigned nloc = b.st[0], nx = b.st[1];
        if (nloc == 0u) { xcd_barrier_complete(bar, b.x, nloc, nx); b.st[0] = nloc; b.st[1] = nx; }
        const unsigned old = xb_add(&bar[XB_XSUB(b.x)], 1u);
        const unsigned gen = old / nloc;
        if (old + 1u == (gen + 1u) * nloc) {
            __builtin_amdgcn_fence(__ATOMIC_RELEASE, "agent");
            asm volatile("s_waitcnt vmcnt(0)" ::: "memory");
            const unsigned og = xb_add(&bar[XB_TOP], 1u);
            const unsigned tg = og / nx;
            if (og + 1u == (tg + 1u) * nx) xb_add(&bar[XB_TOPGEN], 1u);
            else XB_SPIN(xb_ld(&bar[XB_TOPGEN]) == tg, bar);
            __builtin_amdgcn_fence(__ATOMIC_ACQUIRE, "agent");
            xb_add(&bar[XB_XGEN(b.x)], 1u);
            asm volatile("s_waitcnt vmcnt(0)" ::: "memory");
        } else {
            XB_SPIN(xb_ld(&bar[XB_XGEN(b.x)]) == gen, bar);
            __builtin_amdgcn_fence(__ATOMIC_ACQUIRE, "agent");
            asm volatile("s_waitcnt vmcnt(0)" ::: "memory");
        }
    }
    __syncthreads();
}

#ifndef PHMASK
#define PHMASK 0xFFFFFFFF
#endif
#define PH(k) ((PHMASK >> (k)) & 1u)
#ifndef DUPMASK
#define DUPMASK 0u
#endif
#define REP(k) for (int rep_ = 0; rep_ < 1 + (int)((DUPMASK >> (k)) & 1u); ++rep_)
__global__ void __launch_bounds__(NTHR, 2) fwd_megakernel(Params p) {
    extern __shared__ __attribute__((aligned(16))) unsigned char lds_raw[];
    cg::grid_group grid = cg::this_grid();
    char* lds = (char*)lds_raw; LAS unsigned char* ldsl = (LAS unsigned char*)lds_raw;
    unsigned char* ws = p.ws;
    const int G = gridDim.x, bid = blockIdx.x;
    float* mods = (float*)(ws + WS_MODS);
    bf16_t* Pm = (bf16_t*)(ws + WS_R1); bf16_t* ACT = (bf16_t*)(ws + WS_R1);
    bf16_t* UC = (bf16_t*)(ws + WS_R2 + R2_UC); bf16_t* Qm = (bf16_t*)(ws + WS_R2 + R2_Q); bf16_t* KF = (bf16_t*)(ws + WS_R2 + R2_KF); bf16_t* VM = (bf16_t*)(ws + WS_R2 + R2_VM);
    bf16_t* H = (bf16_t*)(ws + WS_R2 + R2_H); bf16_t* Y = (bf16_t*)(ws + WS_R2 + R2_Y);
    float* ABa = (float*)(ws + WS_R3); float* ABb = ABa + (size_t)2 * MROWS * 1024; float* YT0 = (float*)(ws + WS_R3); float* YT1 = (float*)(ws + WS_R3 + 68 * MiB); float* Z = YT0;
    bf16_t* MO = (bf16_t*)(ws + WS_MRN); bf16_t* NO = (bf16_t*)(ws + WS_MRN + 34 * MiB);
    float* rsq = (float*)(ws + WS_RS); float* rskv = rsq + MROWS; const float* cosT = (const float*)(ws + WS_ROPE); const float* sinT = cosT + SEQ * 32;

    if (threadIdx.x < 2) ((volatile LAS unsigned*)(ldsl + LDS_BYTES - 64))[threadIdx.x] = 0u;
    __syncthreads();
    const XcdBarrier xbar = xcd_barrier_post((unsigned*)(ws + WS_BAR), (volatile LAS unsigned*)(ldsl + LDS_BYTES - 64));
    REP(0) { phase0(p, lds); __syncthreads(); }
    if (p.ws == nullptr) grid.sync();
    REP(20) xcd_barrier(xbar);
    row_pass(p, 0, nullptr, nullptr, nullptr, nullptr, 0, p.in[6], mods, 0, 1, H, false);
    REP(20) xcd_barrier(xbar);

#pragma unroll 1
    for (int l = 0; l < 2; ++l) {
        const bool lastl = (l == 1);
        unsigned char* wl = ws + WS_W + (size_t)l * W_LAYER;
        const float* modl = mods + (size_t)l * 3 * 12288;
        float* ZSl = (float*)(ws + WS_ZS);
        REP(2) { pg8::Gemm g{H, (const bf16_t*)(wl + W_IN), DM, DM, DM, 0}; pg8::Order S; S.init(34, 48, G, bid, 0); pg8::EpiP E{Pm, INP}; pg8::gemm_phase(ldsl, g, S, E); }
        if (l == 0) convert_deferred(p, lds, 96, 0, DJ_GU);
        REP(20) xcd_barrier(xbar);
        REP(3) phase_p2(p, l);
        REP(20) xcd_barrier(xbar);
        REP(4) { pg8::Gemm g{Pm, (const bf16_t*)(wl + W_Q), INP, 512, 512, 0}; pg8::Order S; S.init(34, 6, G, bid, 0); pg8::EpiQ E{Qm, rsq, cosT, sinT}; pg8::gemm_phase(ldsl, g, S, E); }
        REP(5) { pg8::Gemm g{Pm + C_KVA, (const bf16_t*)(wl + W_KV), INP, 256, 256, 0}; pg8::Order S; S.init(34, 8, G, (bid + 16) % G, 0); pg8::EpiKV E{KF, VM, rskv};     pg8::gemm_phase(ldsl, g, S, E); }
        REP(6) { pg8::Gemm g{UC, (const bf16_t*)(wl + W_G), 1024, 256, 256, 1}; pg8::Order S; S.init(34, 16, G, (bid + 48) % G, 0); pg8::EpiGate E{UC, p.in[19] + (size_t)l * 2048, p.in[21] + (size_t)l * 2048, (const float*)(ws + WS_SPT) + (size_t)l * 2048, ABa, (f32x2*)(ws + WS_AGG), (f32x2*)(ws + WS_AGG) + (size_t)4 * 136 * 512}; pg8::gemm_phase(ldsl, g, S, E); }
        REP(20) xcd_barrier(xbar);
        REP(7) { scan_s2(p, lds); __syncthreads(); }
        REP(20) xcd_barrier(xbar);
        {
            REP(8) for (int u = bid; u < 256; u += G) {
                const int xcd = u & 7, idx = u >> 3, bh = 2 * xcd + (idx >> 4), qb = idx & 15, b = bh >> 3, h = bh & 7; const long r0 = (long)b * RPB;
                att::attn_unit<192, 0, 1>(Qm + (r0 + CTX + qb * 256) * 1536 + h * 192, 1536, KF + h * 192, 1536, VM + h * 128, 1024, MO + (r0 + CTX + qb * 256) * 1024 + h * 128, 1024,
                                          68, (int)r0, 68, 0, 0, 0, nullptr, lds);
            }
            const float* rpb = p.in[24] + (size_t)l * 8 * 465;
            REP(9) for (int u = bid; u < 256; u += G) {
                const int xcd = u & 7, idx = u >> 3, bh = 2 * xcd + (idx >> 4), rg = idx & 15, b = bh >> 3, h = bh & 7; const long r0 = (long)b * RPB; const int R0 = 4 * rg;
                int lo = min(max(R0 - 4, 0), 56), hi_ = min(max(R0 - 1, 0), 56) + 8; int nlat = hi_ - lo;
                if (nlat & 1) { if (hi_ < 64) ++nlat; else { --lo; ++nlat; } }
                att::attn_unit<128, 1, 1>(Pm + (r0 + CTX + R0 * 64) * INP + C_NQ + h * 128, INP, Pm + C_NK + h * 128, INP, Pm + C_NV + h * 128, INP,
                                          NO + (r0 + CTX + R0 * 64) * 1024 + h * 128, 1024, 4 + nlat, (int)r0, 4, (int)r0 + CTX + lo * 64, R0, lo, rpb + h * 465, lds);
            }
            { unsigned* qctr = (unsigned*)(ws + WS_BAR) + 3600 + 64 * l; volatile LAS unsigned* qslot = (volatile LAS unsigned*)(ldsl + LDS_BYTES - 48);
              const int nctx = lastl ? 0 : 32, ntot = nctx + 2 * NCH;
              for (;;) {
                  __syncthreads();
                  if (threadIdx.x == 0) *qslot = __hip_atomic_fetch_add(qctr, 1u, __ATOMIC_RELAXED, __HIP_MEMORY_SCOPE_AGENT);
                  __syncthreads();
                  const int it = (int)*qslot;
                  if (it >= ntot) break;
                  if (it < nctx) { const int u = it, b = (u >> 3) & 1, h = u & 7; const long r0 = (long)b * RPB;
                      if (u < 16) att::attn_unit<192, 0, 1>(Qm + r0 * 1536 + h * 192, 1536, KF + h * 192, 1536, VM + h * 128, 1024, MO + r0 * 1024 + h * 128, 1024, 4, (int)r0, 4, 0, 0, 0, nullptr, lds);
                      else att::attn_unit<128, 0, 1>(Pm + r0 * INP + C_NQ + h * 128, INP, Pm + C_NK + h * 128, INP, Pm + C_NV + h * 128, INP, NO + r0 * 1024 + h * 128, 1024, 4, (int)r0, 4, 0, 0, 0, nullptr, lds); }
                  else scan_s3_item(p, it - nctx);
              } }
        }
        REP(20) xcd_barrier(xbar);
        REP(12) { pg8::Order S; S.init(32, 8, G, bid, 1);
          { pg8::Gemm g{MO, (const bf16_t*)(wl + W_MRG), 1024, 1024, 1024, 0}; pg8::EpiMerge<0> E{Pm, nullptr, (bf16_t*)YT0}; pg8::gemm_phase(ldsl, g, S, E); }
          { pg8::Gemm g{MO + (size_t)MROWS * 1024, (const bf16_t*)(wl + W_MRG) + (size_t)DM * 1024, 1024, 1024, 1024, 0}; pg8::EpiMerge<1> E{Pm, (const bf16_t*)YT0, (bf16_t*)YT1}; pg8::gemm_phase(ldsl, g, S, E); }
          { pg8::Gemm g{MO + (size_t)2 * MROWS * 1024, (const bf16_t*)(wl + W_MRG) + (size_t)2 * DM * 1024, 1024, 1024, 1024, 0}; pg8::EpiMerge<2> E{Pm, (const bf16_t*)YT1, Y}; pg8::gemm_phase(ldsl, g, S, E); }
          if (!lastl) { pg8::Gemm g{MO, (const bf16_t*)(wl + W_MRG), 1024, 1024, 1024, 3}; pg8::Order S2; S2.init(2, 24, G, bid, 2); pg8::EpiMergeS E{Pm, ZSl}; pg8::gemm_phase(ldsl, g, S2, E); convert_deferred(p, lds, 48, DJ_GU, DJ_GU + 8192); } }
        REP(20) xcd_barrier(xbar);
        if (!lastl) { const int tid = tid_opaque(), lane = tid & 63, gw = bid * NWAVES + (tid >> 6);
            for (int cr = gw; cr < 512; cr += G * NWAVES) { const int row = (cr >> 8) * RPB + (cr & 255);
#pragma unroll
                for (int j = 0; j < 8; ++j) { const float* zp = ZSl + (size_t)cr * DM + 4 * lane + 256 * j;
                    const f32x4 v = *(const f32x4*)zp + *(const f32x4*)(zp + (size_t)512 * DM) + *(const f32x4*)(zp + (size_t)1024 * DM);
                    u32x2 w; w.x = cvt_pk_bf16(v[0], v[1]); w.y = cvt_pk_bf16(v[2], v[3]); *(u32x2*)(Y + (size_t)row * DM + 4 * lane + 256 * j) = w; } } }
        REP(13) { { pg8::Gemm g{Y, (const bf16_t*)(wl + W_OUT), DM, DM, DM, 0}; pg8::Order S; S.init(32, 8, G, bid, 1); pg8::EpiP E{(bf16_t*)Z, DM}; pg8::gemm_phase(ldsl, g, S, E); }
          if (!lastl) xcd_barrier(xbar);
          if (!lastl) { pg8::Gemm g{Y, (const bf16_t*)(wl + W_OUT), DM, DM, DM / 4, 2}; pg8::Order S; S.init(2, 32, G, bid, 2); pg8::EpiF32S E{ZSl}; pg8::gemm_phase(ldsl, g, S, E); convert_deferred(p, lds, 64, DJ_GU + 8192, DJ_IN); } }
        REP(20) xcd_barrier(xbar);
        row_pass(p, l == 0 ? 2 : 1, Z, lastl ? nullptr : ZSl, p.in[7] + (size_t)l * DM, modl, 2, p.in[8] + (size_t)l * DM, modl, 3, 4, H, lastl);
        REP(20) xcd_barrier(xbar);
        REP(15) { pg8::Gemm g{H, (const bf16_t*)(wl + W_GU), DM, DM, DM, 0}; pg8::Order S; S.init(lastl ? 32 : 34, 44, G, bid, lastl ? 1 : 0); pg8::EpiSwiGLU E{ACT}; pg8::gemm_phase(ldsl, g, S, E); if (!lastl) convert_deferred(p, lds, 216, DJ_IN, DJ_IN + 2880); }
        REP(20) xcd_barrier(xbar);
        REP(16) { { pg8::Gemm g{ACT, (const bf16_t*)(wl + W_DN), FF, FF, FF, 0}; pg8::Order S; S.init(32, 8, G, bid, 1); pg8::EpiP E{(bf16_t*)Z, DM}; pg8::gemm_phase(ldsl, g, S, E); }
          if (!lastl) { pg8::Gemm g{ACT, (const bf16_t*)(wl + W_DN), FF, FF, FF / 4, 2}; pg8::Order S; S.init(2, 32, G, bid, 2); pg8::EpiF32S E{ZSl}; pg8::gemm_phase(ldsl, g, S, E); convert_deferred(p, lds, 64, DJ_IN + 2880, DJ_END); } }
        REP(20) xcd_barrier(xbar);
        { if (!lastl) row_pass(p, 1, Z, ZSl, p.in[9] + (size_t)l * DM, modl, 5, p.in[6] + (size_t)(l + 1) * DM, mods + (size_t)(l + 1) * 3 * 12288, 0, 1, H, false);
        else row_pass(p, 3, Z, nullptr, p.in[9] + (size_t)l * DM, modl, 5, nullptr, nullptr, 0, 0, nullptr, true); }
        if (!lastl) REP(20) xcd_barrier(xbar);
    }
}

extern "C" void kernel_launch(void* const* d_in, const int* in_sizes, int n_in, void* d_out, int out_size, void* d_ws, size_t ws_size, hipStream_t stream) {
    static int grid_blocks = 0;
    if (grid_blocks == 0) {
        if (n_in != 30 || ws_size < WS_END) { fprintf(stderr, "kernel_launch: unexpected n_in %d or workspace %zu < %zu\n", n_in, ws_size, (size_t)WS_END); grid_blocks = -1; return; }
        int dev = 0, cus = 0, per_cu = 0;
        hipGetDevice(&dev);
        hipDeviceGetAttribute(&cus, hipDeviceAttributeMultiprocessorCount, dev);
        hipFuncSetAttribute((const void*)fwd_megakernel, hipFuncAttributeMaxDynamicSharedMemorySize, LDS_BYTES);
        hipOccupancyMaxActiveBlocksPerMultiprocessor(&per_cu, (const void*)fwd_megakernel, NTHR, LDS_BYTES);
        if (per_cu < 1) per_cu = 1;
        grid_blocks = cus * per_cu;
        if (grid_blocks > 256) grid_blocks = 256;
    }
    if (grid_blocks < 0) return;
    Params p{};
    for (int i = 0; i < 30; ++i) p.in[i] = (const float*)d_in[i];
    p.out = (float*)d_out; p.ws = (unsigned char*)d_ws;
    (void)hipMemsetAsync((unsigned char*)d_ws + WS_BAR, 0, BAR_BYTES, stream);
    void* args[] = {&p};
    hipError_t e = hipLaunchCooperativeKernel((const void*)fwd_megakernel, dim3(grid_blocks), dim3(NTHR), args, LDS_BYTES, stream);
    if (e != hipSuccess) fprintf(stderr, "cooperative launch failed: %s (grid %d)\n", hipGetErrorString(e), grid_blocks);
}
```
